# Optimizing an MI355X kernel written in HIP

```python
import jax, jax.numpy as jnp
from jax import lax
import numpy as np

D_MODEL = 2048
BATCH = 1
SEQ = 8192
DEPTH = 1
DEC_BATCH = 32
DEC_SEQ = 16
PAST_LEN = 1024

CHUNK = 64
N_META = 16
EPS = 1e-6

GLA_HEADS = 4
GLA_DK = D_MODEL // 2 // GLA_HEADS
GLA_DV = D_MODEL // GLA_HEADS
GLA_RANK = 16
GLA_GATE_NORM = 16.0
GLA_BLOCK = 16
GLA_LOG_ALPHA_MIN = -5.0

MLA_HEADS = 16
MLA_Q_RANK = 512
MLA_KV_RANK = 512
MLA_NOPE = 128
MLA_ROPE = 64
MLA_V = 128
ROPE_THETA = 10000.0
Q_BLOCK = 128

D_FF = 5632
CONV_W = 3

GLA_QK = GLA_HEADS * GLA_DK
GLA_VW = GLA_HEADS * GLA_DV
MLA_QW = MLA_HEADS * (MLA_NOPE + MLA_ROPE)
IN_SPLITS = (GLA_QK, GLA_QK, GLA_VW, GLA_VW, GLA_RANK, MLA_Q_RANK, MLA_KV_RANK, MLA_ROPE, D_MODEL, D_MODEL)
IN_COLS = sum(IN_SPLITS)

kernel_name = "hybrid_gla_mla_convffn_stream_step"


def rmsnorm(x, g):
    x32 = x.astype(jnp.float32)
    y = x32 * lax.rsqrt(jnp.mean(x32 * x32, axis=-1, keepdims=True) + EPS)
    return (y * g.astype(jnp.float32)).astype(x.dtype)


def split_cols(h):
    out, start = [], 0
    for w in IN_SPLITS:
        out.append(h[..., start:start + w])
        start += w
    return out


def rope_angles(pos):
    inv = ROPE_THETA ** (-jnp.arange(0, MLA_ROPE, 2, dtype=jnp.float32) / MLA_ROPE)
    ang = pos.astype(jnp.float32)[:, None] * inv[None, :]
    return jnp.cos(ang), jnp.sin(ang)


def apply_rope(x, cos, sin):
    x32 = x.astype(jnp.float32)
    x1, x2 = x32[..., :MLA_ROPE // 2], x32[..., MLA_ROPE // 2:]
    return jnp.concatenate([x1 * cos - x2 * sin, x2 * cos + x1 * sin], -1).astype(x.dtype)


def gla_recurrence(q, k, v, log_a, s0):
    B, T, H, _ = q.shape
    pad = (-T) % GLA_BLOCK
    nb = (T + pad) // GLA_BLOCK

    def blk(a):
        a = jnp.pad(a.astype(jnp.float32), ((0, 0), (0, pad), (0, 0), (0, 0)))
        return a.reshape(B, nb, GLA_BLOCK, H, a.shape[-1])

    q, k, v, log_a = blk(q), blk(k), blk(v), blk(log_a)
    b = jnp.cumsum(log_a, axis=2)
    b_last = b[:, :, -1:]
    q_dec = q * jnp.exp(b)
    k_inv = k * jnp.exp(-b)
    k_end = k * jnp.exp(b_last - b)
    causal = jnp.tril(jnp.ones((GLA_BLOCK, GLA_BLOCK), dtype=bool))
    att = jnp.where(causal, jnp.einsum("bnchd,bnshd->bnhcs", q_dec, k_inv), 0.0)
    o_intra = jnp.einsum("bnhcs,bnshe->bnche", att, v)
    decay = jnp.exp(b_last[:, :, 0])

    def step(S, inp):
        q_n, k_n, v_n, d_n = inp
        o_n = jnp.einsum("bchd,bhde->bche", q_n, S)
        S = d_n[..., None] * S + jnp.einsum("bchd,bche->bhde", k_n, v_n)
        return S, o_n

    xs = tuple(jnp.moveaxis(a, 1, 0) for a in (q_dec, k_end, v, decay))
    S, o_inter = lax.scan(step, s0.astype(jnp.float32), xs)
    o = o_intra + jnp.moveaxis(o_inter, 0, 1)
    return o.reshape(B, nb * GLA_BLOCK, H, v.shape[-1])[:, :T], S


def attend(q_nope, q_pe, k_nope, k_pe, v, q_chunk, k_chunk):
    scale = (MLA_NOPE + MLA_ROPE) ** -0.5
    s = (jnp.einsum("bqhd,bkhd->bhqk", q_nope, k_nope).astype(jnp.float32)
         + jnp.einsum("bqhr,bkr->bhqk", q_pe, k_pe).astype(jnp.float32)) * scale
    visible = q_chunk[:, None] >= k_chunk[None, :]
    p = jax.nn.softmax(jnp.where(visible, s, -1e30), axis=-1)
    return jnp.einsum("bhqk,bkhe->bqhe", p.astype(v.dtype), v)


def block_causal_attention(q_nope, q_pe, k_nope, k_pe, v, q_chunk, k_chunk):
    B, Tq = q_nope.shape[:2]
    if Tq <= Q_BLOCK:
        return attend(q_nope, q_pe, k_nope, k_pe, v, q_chunk, k_chunk)
    pad = (-Tq) % Q_BLOCK
    nq = (Tq + pad) // Q_BLOCK

    def blocks(a):
        a = jnp.pad(a, [(0, 0), (0, pad)] + [(0, 0)] * (a.ndim - 2))
        return jnp.moveaxis(a.reshape(B, nq, Q_BLOCK, *a.shape[2:]), 1, 0)

    qc = jnp.pad(q_chunk, (0, pad), mode="edge").reshape(nq, Q_BLOCK)
    out = lax.map(lambda a: attend(a[0], a[1], k_nope, k_pe, v, a[2], k_chunk),
                  (blocks(q_nope), blocks(q_pe), qc))
    out = jnp.moveaxis(out, 0, 1).reshape(B, nq * Q_BLOCK, MLA_HEADS, v.shape[-1])
    return out[:, :Tq]


def trunk_layer(x, pos, q_chunk, past_latent, past_krope, past_chunk, gla_state, conv_hist,
                g_mix, w_in, w_a2, b_a, g_gla_out, g_q, w_uq, g_kv, w_uk, w_uv, w_o,
                g_ffn, w_up, conv_w, conv_b, w_down):
    B, T, _ = x.shape
    h = rmsnorm(x, g_mix)
    q_g, k_g, v_g, r_g, a_g, c_q, c_kv, k_pe, gate_a, gate_b = split_cols(h @ w_in)

    q_g = q_g.reshape(B, T, GLA_HEADS, GLA_DK) * (GLA_DK ** -0.5)
    k_g = k_g.reshape(B, T, GLA_HEADS, GLA_DK)
    v_g = v_g.reshape(B, T, GLA_HEADS, GLA_DV)
    log_a = jax.nn.log_sigmoid((a_g @ w_a2 + b_a).astype(jnp.float32)) / GLA_GATE_NORM
    log_a = jnp.maximum(log_a, GLA_LOG_ALPHA_MIN).reshape(B, T, GLA_HEADS, GLA_DK)
    o_g, new_state = gla_recurrence(q_g, k_g, v_g, log_a, gla_state)
    o_g = rmsnorm(o_g.astype(x.dtype), g_gla_out).reshape(B, T, GLA_VW)
    branch_a = o_g * jax.nn.silu(r_g)

    q = (rmsnorm(c_q, g_q) @ w_uq).reshape(B, T, MLA_HEADS, MLA_NOPE + MLA_ROPE)
    q_nope, q_pe = q[..., :MLA_NOPE], q[..., MLA_NOPE:]
    latent = rmsnorm(c_kv, g_kv)
    cos, sin = rope_angles(pos)
    k_pe = apply_rope(k_pe, cos, sin)
    q_pe = apply_rope(q_pe, cos[:, None], sin[:, None])
    all_latent = jnp.concatenate([past_latent.astype(latent.dtype), latent], 1)
    all_kpe = jnp.concatenate([past_krope.astype(k_pe.dtype), k_pe], 1)
    Tk = all_latent.shape[1]
    k_nope = (all_latent @ w_uk).reshape(B, Tk, MLA_HEADS, MLA_NOPE)
    v = (all_latent @ w_uv).reshape(B, Tk, MLA_HEADS, MLA_V)
    k_chunk = jnp.concatenate([past_chunk, q_chunk])
    o_m = block_causal_attention(q_nope, q_pe, k_nope, all_kpe, v, q_chunk, k_chunk)
    branch_b = o_m.reshape(B, T, MLA_HEADS * MLA_V)

    merged = jax.nn.sigmoid(gate_a) * branch_a + jax.nn.sigmoid(gate_b) * branch_b
    x = x + merged @ w_o

    u = rmsnorm(x, g_ffn) @ w_up
    u_ext = jnp.concatenate([conv_hist.astype(u.dtype), u], 1)
    c = conv_b + conv_w[0] * u_ext[:, 0:T]
    for j in range(1, CONV_W):
        c = c + conv_w[j] * u_ext[:, j:j + T]
    x = x + (jax.nn.silu(c[..., :D_FF]) * c[..., D_FF:]) @ w_down
    return x, latent, k_pe, new_state.astype(x.dtype), u_ext[:, -(CONV_W - 1):]


def setup_inputs(seed: int = 0) -> dict:
    key = jax.random.key(seed)
    ks = jax.random.split(key, 32)
    f32 = jnp.float32

    def nrm(k, shape, scale):
        return scale * jax.random.normal(k, shape, f32)

    def gain(k, shape):
        return 1.0 + 0.02 * jax.random.normal(k, shape, f32)

    return {
        "x_prompt": nrm(ks[0], (BATCH, SEQ, D_MODEL), 1.0),
        "x_sample": nrm(ks[1], (DEC_BATCH, DEC_SEQ, D_MODEL), 1.0),
        "cache_mla_latent": nrm(ks[2], (DEPTH, DEC_BATCH, PAST_LEN, MLA_KV_RANK), 1.0),
        "cache_mla_krope": nrm(ks[3], (DEPTH, DEC_BATCH, PAST_LEN, MLA_ROPE), 1.0),
        "state_gla": nrm(ks[4], (DEPTH, DEC_BATCH, GLA_HEADS, GLA_DK, GLA_DV), 1.0),
        "cache_ffn_conv": nrm(ks[5], (DEPTH, DEC_BATCH, CONV_W - 1, 2 * D_FF), 1.0),
        "meta_tokens": nrm(ks[6], (N_META, D_MODEL), 1.0),
        "g_mix": gain(ks[7], (DEPTH, D_MODEL)),
        "w_in": nrm(ks[8], (DEPTH, D_MODEL, IN_COLS), D_MODEL ** -0.5),
        "w_a2": nrm(ks[9], (DEPTH, GLA_RANK, GLA_QK), GLA_RANK ** -0.5),
        "b_a": nrm(ks[10], (DEPTH, GLA_QK), 0.1),
        "g_gla_out": gain(ks[11], (DEPTH, GLA_DV)),
        "g_q": gain(ks[12], (DEPTH, MLA_Q_RANK)),
        "w_uq": nrm(ks[13], (DEPTH, MLA_Q_RANK, MLA_QW), MLA_Q_RANK ** -0.5),
        "g_kv": gain(ks[14], (DEPTH, MLA_KV_RANK)),
        "w_uk": nrm(ks[15], (DEPTH, MLA_KV_RANK, MLA_HEADS * MLA_NOPE), MLA_KV_RANK ** -0.5),
        "w_uv": nrm(ks[16], (DEPTH, MLA_KV_RANK, MLA_HEADS * MLA_V), MLA_KV_RANK ** -0.5),
        "w_o": nrm(ks[17], (DEPTH, D_MODEL, D_MODEL), D_MODEL ** -0.5),
        "g_ffn": gain(ks[18], (DEPTH, D_MODEL)),
        "w_up": nrm(ks[19], (DEPTH, D_MODEL, 2 * D_FF), D_MODEL ** -0.5),
        "conv_w": nrm(ks[20], (DEPTH, CONV_W, 2 * D_FF), CONV_W ** -0.5),
        "conv_b": nrm(ks[21], (DEPTH, 2 * D_FF), 0.02),
        "w_down": nrm(ks[22], (DEPTH, D_FF, D_MODEL), D_FF ** -0.5),
        "final_norm": gain(ks[23], (D_MODEL,)),
    }


def reference(x_prompt, x_sample, cache_mla_latent, cache_mla_krope, state_gla, cache_ffn_conv,
              meta_tokens, g_mix, w_in, w_a2, b_a, g_gla_out, g_q, w_uq, g_kv, w_uk, w_uv, w_o,
              g_ffn, w_up, conv_w, conv_b, w_down, final_norm):
    B, T_p, _ = x_prompt.shape
    T_s = x_sample.shape[1]
    P = cache_mla_latent.shape[2]
    dt = x_prompt.dtype

    xp = jnp.concatenate([jnp.broadcast_to(meta_tokens.astype(dt)[None], (B, N_META, D_MODEL)), x_prompt], 1)
    idx = jnp.arange(T_p + N_META, dtype=jnp.int32)
    chunk_p = jnp.where(idx < N_META, -1, (idx - N_META) // CHUNK).astype(jnp.int32)
    no_chunk = jnp.zeros((0,), jnp.int32)
    pos_s = P + jnp.arange(T_s, dtype=jnp.int32)
    chunk_s = pos_s // CHUNK
    past_chunk_s = jnp.arange(P, dtype=jnp.int32) // CHUNK
    xs = x_sample

    lat_p, kpe_p, gla_p, conv_p = [], [], [], []
    lat_s, kpe_s, gla_s, conv_s = [], [], [], []
    for l in range(DEPTH):
        wl = (g_mix[l], w_in[l], w_a2[l], b_a[l], g_gla_out[l], g_q[l], w_uq[l], g_kv[l],
              w_uk[l], w_uv[l], w_o[l], g_ffn[l], w_up[l], conv_w[l], conv_b[l], w_down[l])
        xp, lat, kpe, st, cv = trunk_layer(
            xp, idx, chunk_p,
            jnp.zeros((B, 0, MLA_KV_RANK), dt), jnp.zeros((B, 0, MLA_ROPE), dt), no_chunk,
            jnp.zeros((B, GLA_HEADS, GLA_DK, GLA_DV), jnp.float32),
            jnp.zeros((B, CONV_W - 1, 2 * D_FF), dt), *wl)
        lat_p.append(lat); kpe_p.append(kpe); gla_p.append(st); conv_p.append(cv)
        xs, lat, kpe, st, cv = trunk_layer(
            xs, pos_s, chunk_s, cache_mla_latent[l], cache_mla_krope[l], past_chunk_s,
            state_gla[l], cache_ffn_conv[l], *wl)
        lat_s.append(lat); kpe_s.append(kpe); gla_s.append(st); conv_s.append(cv)

    y_prompt = rmsnorm(xp, final_norm)[:, N_META:]
    y_sample = rmsnorm(xs, final_norm)
    return (y_prompt, y_sample,
            jnp.stack(lat_p), jnp.stack(kpe_p), jnp.stack(gla_p), jnp.stack(conv_p),
            jnp.stack(lat_s), jnp.stack(kpe_s), jnp.stack(gla_s), jnp.stack(conv_s))
```

```cpp
#include <hip/hip_runtime.h>
#include <cstdio>
#include <cstdint>

#define LAS __attribute__((address_space(3)))
#define GAS __attribute__((address_space(1)))
typedef unsigned short bf16_t;
typedef short bf16x8 __attribute__((ext_vector_type(8)));
typedef short s16x4 __attribute__((ext_vector_type(4)));
typedef float f32x2 __attribute__((ext_vector_type(2)));
typedef float f32x4 __attribute__((ext_vector_type(4)));
typedef float f32x16 __attribute__((ext_vector_type(16)));
typedef unsigned u32x2 __attribute__((ext_vector_type(2)));
typedef unsigned u32x4 __attribute__((ext_vector_type(4)));
typedef __bf16 bf16x2_t __attribute__((ext_vector_type(2)));
typedef GAS unsigned gu32;

#define MFMA32(a, b, c) __builtin_amdgcn_mfma_f32_32x32x16_bf16((a), (b), (c), 0, 0, 0)
#define MFMA16(a, b, c) __builtin_amdgcn_mfma_f32_16x16x32_bf16((a), (b), (c), 0, 0, 0)
#define RLX_AGENT __ATOMIC_RELAXED, __HIP_MEMORY_SCOPE_AGENT

__device__ __forceinline__ unsigned pk2(float lo, float hi) { f32x2 v = {lo, hi}; bf16x2_t b = __builtin_convertvector(v, bf16x2_t); return __builtin_bit_cast(unsigned, b); }
__device__ __forceinline__ float bflo(unsigned u) { return __uint_as_float(u << 16); }
__device__ __forceinline__ float bfhi(unsigned u) { return __uint_as_float(u & 0xffff0000u); }
__device__ __forceinline__ float bf1(bf16_t u) { return __uint_as_float(((unsigned)u) << 16); }
__device__ __forceinline__ bf16_t f2bf(float f) { return (bf16_t)(pk2(f, 0.f) & 0xffffu); }
__device__ __forceinline__ int lane_now() { int l; asm volatile("v_mbcnt_lo_u32_b32 %0, -1, 0\n\tv_mbcnt_hi_u32_b32 %0, -1, %0" : "=v"(l)); return l; }
__device__ __forceinline__ float wave_sum(float v) {
#pragma unroll
    for (int o = 1; o < 64; o <<= 1) v += __shfl_xor(v, o);
    return v;
}
__device__ __forceinline__ float sigmoidf_(float x) { return 1.f / (1.f + __expf(-x)); }
__device__ __forceinline__ s16x4 lds_tr(LAS const unsigned char* p) { typedef short v4i16_t __attribute__((ext_vector_type(4))); return __builtin_bit_cast(s16x4, __builtin_amdgcn_ds_read_tr16_b64_v4i16((LAS v4i16_t*)p)); }
__device__ __forceinline__ bf16x8 cat8(s16x4 lo, s16x4 hi) { return (bf16x8){lo[0], lo[1], lo[2], lo[3], hi[0], hi[1], hi[2], hi[3]}; }

constexpr int DM = 2048, T_P = 8192, N_META = 16, DEC_B = 32, DEC_T = 16, PAST = 1024, TK_S = PAST + DEC_T;
constexpr int R_SAMPLE = 8192, R_META = 8704, M_REAL = 8720, M_PAD = 8960, NMT = 35;
constexpr int NH = 11520;
constexpr int HC_Q = 0, HC_K = 1024, HC_V = 2048, HC_R = 4096, HC_CQ = 6144, HC_CKV = 6656, HC_GA = 7168, HC_GB = 9216, HC_KPE = 11264, HC_AG = 11328;
constexpr int IN_COLS = 11344;
constexpr int QP = 3072;
constexpr int DFF = 5632, DFF2 = 11264;
constexpr float EPS = 1e-6f;
constexpr float QSCALE = 0.07216878364870322f * 1.4426950408889634f;

constexpr size_t O_YP = 0, O_YS = 16777216, O_LATP = 17825792, O_KRP = 22028288, O_GSP = 22553600, O_CVP = 23077888, O_LATS = 23100416, O_KRS = 23362560, O_GSS = 23395328, O_CVS = 40172544, O_END = 40893440;

constexpr size_t MiB = 1u << 20;
constexpr size_t WS_CTL = 0, CTL_ZERO_BYTES = 256 * 1024;
constexpr size_t WS_RSX = 1 * MiB;
constexpr size_t WS_SS = 1 * MiB + 256 * 1024;
constexpr size_t WS_SS2 = 2 * MiB;
constexpr size_t WS_ROPE = 3 * MiB + 512 * 1024;
constexpr size_t WS_DECP = 6 * MiB;
constexpr size_t WS_DECS = 6 * MiB + 640 * 1024;
constexpr size_t WS_KPE = 6 * MiB + 768 * 1024;
constexpr size_t WS_WOT = 8 * MiB, WS_WUVT = 16 * MiB, WS_WQT = 18 * MiB, WS_WKVT = 21 * MiB, WS_WUKN = 25 * MiB, WS_WUQN = 27 * MiB, WS_WABS = 30 * MiB, WS_X2M = 38 * MiB;
constexpr size_t WS_H = 40 * MiB;
constexpr size_t WS_R3 = 238 * MiB;
constexpr size_t WS_XBF = WS_R3, WS_W1T = WS_R3 + 35 * MiB;
constexpr size_t WS_Q = WS_R3, WS_SKL = WS_R3 + 53 * MiB, WS_SKP = WS_R3 + 86 * MiB, WS_QLAT = WS_R3 + 91 * MiB;
constexpr size_t WS_X2B = WS_R3, WS_WUPT = WS_R3 + 53 * MiB;
constexpr size_t WS_GATE = WS_R3;
constexpr size_t WS_R4 = 338 * MiB;
constexpr size_t WS_KV = WS_R4, WS_KET = WS_R4 + 66 * MiB;
constexpr size_t WS_MERGED = WS_R4, WS_WDT = WS_R4 + 35 * MiB;
constexpr size_t WS_END = 422 * MiB;
static_assert(WS_W1T + (size_t)NH * DM * 2 <= WS_R4 && WS_QLAT + (size_t)512 * 8192 * 2 <= WS_R4 && WS_SKL + (size_t)DEC_B * TK_S * 512 * 2 <= WS_SKP && WS_SKP + (size_t)DEC_B * TK_S * 64 * 2 <= WS_QLAT, "R3 map");
static_assert(WS_Q + (size_t)M_PAD * QP * 2 <= WS_SKL && WS_WUPT + (size_t)DFF2 * DM * 2 <= WS_R4 && WS_GATE + (size_t)M_PAD * DFF * 2 <= WS_R4, "R3 map 2");
static_assert(WS_KV + (size_t)33 * 256 * 4096 * 2 <= WS_KET && WS_KET + (size_t)140 * 4 * 256 * 64 * 2 <= WS_END && WS_WDT + (size_t)DM * DFF * 2 <= WS_END && WS_MERGED + (size_t)M_PAD * DM * 2 <= WS_WDT, "R4 map");
static_assert(WS_H + (size_t)M_PAD * NH * 2 <= WS_R3 && WS_WABS + (size_t)8192 * 512 * 2 <= WS_X2M && WS_X2M + 2 * MiB <= WS_H, "H map");
constexpr int CW_BAR = 1024;
constexpr int CW_QUEUE = 8192;

constexpr int RING_BYTES = 131072, MISC_OFF = 135168, LDS_BYTES = 147456;
#define XB_TMO      128
#define XB_XCNT(j)  (256  + 64 * (j))
#define XB_XSUB(j)  (1280 + 64 * (j))
#define XB_XGEN(j)  (2304 + 64 * (j))
#define XB_TOP      3328
#define XB_TOPGEN   3392
#define XCD_BAR_WORDS 3456
#define XB_SPIN_CAP (1u << 18)
__device__ __forceinline__ unsigned xb_ld(unsigned* p)              { return __hip_atomic_load(p, __ATOMIC_RELAXED, __HIP_MEMORY_SCOPE_AGENT); }
__device__ __forceinline__ unsigned xb_add(unsigned* p, unsigned v) { return __hip_atomic_fetch_add(p, v, __ATOMIC_RELAXED, __HIP_MEMORY_SCOPE_AGENT); }
__device__ __forceinline__ unsigned xb_xcc_id() { return (unsigned)__builtin_amdgcn_s_getreg((3 << 11) | 20) & 0xFu; }
#define XB_SPIN(cond, bar) do { unsigned _sp = 0; while (cond) { __builtin_amdgcn_s_sleep(1); \
    if ((++_sp & 255u) == 0u) { if (xb_ld(&(bar)[XB_TMO])) break; if (_sp > XB_SPIN_CAP) { atomicAdd(&(bar)[XB_TMO], 1u); break; } } } } while (0)
struct XcdBarrier { unsigned* bar; unsigned x; volatile LAS unsigned* st; };
__device__ __forceinline__ XcdBarrier xcd_barrier_post(unsigned* bar, volatile LAS unsigned* st, bool tid0) {
    XcdBarrier b; b.bar = bar; b.x = xb_xcc_id(); b.st = st;
    if (tid0) (void)xb_add(&bar[XB_XCNT(b.x)], 1u);
    return b;
}
__device__ __forceinline__ void xcd_barrier_complete(unsigned* bar, unsigned x, unsigned& nloc, unsigned& nx) {
    const unsigned G = gridDim.x * gridDim.y * gridDim.z;
    unsigned sum, cnt, mine, sp = 0u;
    for (;;) {
        sum = 0u; cnt = 0u; mine = 0u;
#pragma unroll
        for (unsigned j = 0; j < 16; ++j) { const unsigned c = xb_ld(&bar[XB_XCNT(j)]); sum += c; cnt += (c > 0u) ? 1u : 0u; mine = (j == x) ? c : mine; }
        if (sum == G) break;
        __builtin_amdgcn_s_sleep(1);
        if ((++sp & 255u) == 0u) { if (xb_ld(&bar[XB_TMO])) break; if (sp > XB_SPIN_CAP) { atomicAdd(&bar[XB_TMO], 1u); break; } }
    }
    nloc = mine > 0u ? mine : 1u; nx = cnt > 0u ? cnt : 1u;
}
__device__ __forceinline__ void xcd_barrier(const XcdBarrier& b, int wave) {
    asm volatile("s_waitcnt vmcnt(0)" ::: "memory");
    __syncthreads();
    if (wave == 0 && lane_now() == 0) {
        unsigned* bar = b.bar;
        __builtin_amdgcn_s_waitcnt(0);
        unsigned nloc = b.st[0], nx = b.st[1];
        if (nloc == 0u) { xcd_barrier_complete(bar, b.x, nloc, nx); b.st[0] = nloc; b.st[1] = nx; }
        const unsigned old = xb_add(&bar[XB_XSUB(b.x)], 1u);
        const unsigned gen = old / nloc;
        if (old + 1u == (gen + 1u) * nloc) {
            __builtin_amdgcn_fence(__ATOMIC_RELEASE, "agent");
            asm volatile("s_waitcnt vmcnt(0)" ::: "memory");
            const unsigned og = xb_add(&bar[XB_TOP], 1u);
            const unsigned tg = og / nx;
            if (og + 1u == (tg + 1u) * nx) xb_add(&bar[XB_TOPGEN], 1u);
            else XB_SPIN(xb_ld(&bar[XB_TOPGEN]) == tg, bar);
            __builtin_amdgcn_fence(__ATOMIC_ACQUIRE, "agent");
            xb_add(&bar[XB_XGEN(b.x)], 1u);
            asm volatile("s_waitcnt vmcnt(0)" ::: "memory");
        } else {
            XB_SPIN(xb_ld(&bar[XB_XGEN(b.x)]) == gen, bar);
            __builtin_amdgcn_fence(__ATOMIC_ACQUIRE, "agent");
            asm volatile("s_waitcnt vmcnt(0)" ::: "memory");
        }
    }
    __syncthreads();
}

namespace pg8 {
constexpr int BM = 256, BK = 64, HALF = 128, HTB = HALF * BK * 2, STAGE_BYTES = 8 * HTB;
__host__ __device__ __forceinline__ int lds_byte(int r, int c) { const int st = (r >> 4) * 2 + (c >> 5), rr = r & 15, cc = c & 31, ob = rr * 64 + cc * 2; return st * 1024 + (ob ^ (((ob >> 9) & 1) << 5)); }
__host__ __device__ __forceinline__ void stage_rc(int b, int& R, int& C) { const int st = b / 1024, sb = b % 1024, swz = sb ^ (((sb >> 9) & 1) << 5); R = (st >> 1) * 16 + swz / 64; C = (st & 1) * 32 + (swz % 64) / 2; }
__host__ __device__ __forceinline__ int perm32(int rho) { const int n = rho >> 4, i = rho & 15; return 8 * (i >> 2) + 4 * n + (i & 3); }
struct Unit { int pm, pn, kind; };
typedef f32x4 Acc[2][2][4][2];

template <class Epi, class Sched>
__device__ __forceinline__ void gemm_phase(LAS unsigned char* lds, const int wid, const int lda, const int ldb, const int K, const Sched& S, const Epi& E) {
    const int lane = lane_now(), tid = wid * 64 + lane, wr = wid >> 2, wc = wid & 3, fr = lane & 15, fq = lane >> 4;
    const int nt = K / BK;
    unsigned voffA[2], voffB[2];
#pragma unroll
    for (int i = 0; i < 2; ++i) { int R, C; stage_rc(tid * 16 + i * 8192, R, C); const int Rb = Epi::PERM ? ((R & ~31) + perm32(R & 31)) : R;
        voffA[i] = (unsigned)(R * lda + C) * 2u; voffB[i] = (unsigned)(Rb * ldb + C) * 2u; }
    const size_t kstep = (size_t)(BK * 2);
    const size_t hstepA = (size_t)HALF * lda * 2;
    const unsigned ldsw = (unsigned)wid * 1024u;
    const int aoff = lds_byte(wr * 64 + fr, fq * 8), boff = lds_byte(wc * 32 + fr, fq * 8);
#define PG8_SA(b, h) (((b) * 2 + (h)) * HTB)
#define PG8_SB(b, h) ((4 + (b) * 2 + (h)) * HTB)
#define PG8_STAGE(bufoff, gbase, voff) do { _Pragma("unroll") for (int _i = 0; _i < 2; ++_i) \
        __builtin_amdgcn_global_load_lds((const unsigned*)((const char*)(gbase) + (voff)[_i]), (LAS unsigned*)(lds + (bufoff) + ldsw + _i * 8192), 16, 0, 0); } while (0)
#define PG8_LDA(dst, b, h) do { _Pragma("unroll") for (int m = 0; m < 4; ++m) _Pragma("unroll") for (int k = 0; k < 2; ++k) dst[m][k] = *(const LAS bf16x8*)(lds + PG8_SA(b, h) + aoff + m * 2048 + k * 1024); } while (0)
#define PG8_LDB(dst, b, h) do { _Pragma("unroll") for (int n = 0; n < 2; ++n) _Pragma("unroll") for (int k = 0; k < 2; ++k) dst[n][k] = *(const LAS bf16x8*)(lds + PG8_SB(b, h) + boff + n * 2048 + k * 1024); } while (0)
#define PG8_MMA(ai, bj, At, Bt) do { __builtin_amdgcn_s_setprio(1); _Pragma("unroll") for (int m = 0; m < 4; ++m) _Pragma("unroll") for (int n = 0; n < 2; ++n) _Pragma("unroll") for (int k = 0; k < 2; ++k) \
        acc[ai][bj][m][n] = __builtin_amdgcn_mfma_f32_16x16x32_bf16(Bt[n][k], At[m][k], acc[ai][bj][m][n], 0, 0, 0); __builtin_amdgcn_s_setprio(0); } while (0)
#define PG8_WAIT_V(n) asm volatile("s_waitcnt vmcnt(" #n ")" ::: "memory")
#define PG8_WAIT_L(n) asm volatile("s_waitcnt lgkmcnt(" #n ")" ::: "memory")
#define PG8_BAR __builtin_amdgcn_s_barrier()
#define PG8_SCHED __builtin_amdgcn_sched_barrier(0)
    Unit cur, nxt; int ui = 0;
    if (!S.next(0, cur)) return;
    f32x4 acc[2][2][4][2];
#pragma unroll
    for (int a = 0; a < 2; ++a)
#pragma unroll
        for (int b = 0; b < 2; ++b)
#pragma unroll
            for (int m = 0; m < 4; ++m)
#pragma unroll
                for (int n = 0; n < 2; ++n) acc[a][b][m][n] = (f32x4){0.f, 0.f, 0.f, 0.f};
    bf16x8 At[4][2], B0[2][2], B1[2][2];
    const char* cA = S.a_ptr(cur); const char* cB0 = S.b_ptr(cur, 0); const char* cB1 = S.b_ptr(cur, 1);
    PG8_STAGE(PG8_SB(0, 0), cB0, voffB); PG8_STAGE(PG8_SB(0, 1), cB1, voffB); PG8_STAGE(PG8_SA(0, 0), cA, voffA); PG8_STAGE(PG8_SA(0, 1), cA + hstepA, voffA);
    if (wr == 1) PG8_BAR;
    PG8_WAIT_V(2); PG8_BAR;
    PG8_STAGE(PG8_SB(1, 0), cB0 + kstep, voffB); PG8_STAGE(PG8_SA(1, 0), cA + kstep, voffA); PG8_STAGE(PG8_SB(1, 1), cB1 + kstep, voffB);
    PG8_WAIT_V(6); PG8_BAR;
    for (;;) {
        const bool has_next = S.next(ui + 1, nxt);
        const char* nA = has_next ? S.a_ptr(nxt) : cA; const char* nB0 = has_next ? S.b_ptr(nxt, 0) : cB0; const char* nB1 = has_next ? S.b_ptr(nxt, 1) : cB1;
        for (int t = 0; t < nt; t += 2) {
            const bool last = (t == nt - 2);
            const char* a1 = cA + (size_t)(t + 1) * kstep;
            const char* a2 = last ? nA : cA + (size_t)(t + 2) * kstep;
            const char* b20 = last ? nB0 : cB0 + (size_t)(t + 2) * kstep; const char* b21 = last ? nB1 : cB1 + (size_t)(t + 2) * kstep;
            const char* a3 = a2 + kstep; const char* b30 = b20 + kstep; const char* b31 = b21 + kstep;
            PG8_LDB(B0, 0, 0); PG8_LDB(B1, 0, 1); PG8_SCHED; PG8_LDA(At, 0, 0); PG8_STAGE(PG8_SA(1, 1), a1 + hstepA, voffA);
            PG8_WAIT_V(8); PG8_WAIT_L(0); PG8_BAR; PG8_MMA(0, 0, At, B0); PG8_MMA(0, 1, At, B1); PG8_BAR; PG8_SCHED;
            PG8_LDA(At, 0, 1); PG8_STAGE(PG8_SB(0, 0), b20, voffB); PG8_STAGE(PG8_SB(0, 1), b21, voffB); PG8_STAGE(PG8_SA(0, 0), a2, voffA);
            PG8_WAIT_V(8); PG8_WAIT_L(0); PG8_BAR; PG8_MMA(1, 0, At, B0); PG8_MMA(1, 1, At, B1); PG8_BAR; PG8_SCHED;
            PG8_LDB(B0, 1, 0); PG8_LDB(B1, 1, 1); PG8_SCHED; PG8_LDA(At, 1, 0); PG8_STAGE(PG8_SA(0, 1), a2 + hstepA, voffA);
            PG8_WAIT_V(8); PG8_WAIT_L(0); PG8_BAR; PG8_MMA(0, 0, At, B0); PG8_MMA(0, 1, At, B1); PG8_BAR; PG8_SCHED;
            PG8_LDA(At, 1, 1); PG8_STAGE(PG8_SB(1, 0), b30, voffB); PG8_STAGE(PG8_SB(1, 1), b31, voffB); PG8_STAGE(PG8_SA(1, 0), a3, voffA);
            PG8_WAIT_V(8); PG8_WAIT_L(0); PG8_BAR; PG8_MMA(1, 0, At, B0); PG8_MMA(1, 1, At, B1); PG8_BAR; PG8_SCHED;
        }
        if (wr == 0) PG8_BAR;
        E(acc, cur, wr, wc, fr, fq);
        if (!has_next) break;
#pragma unroll
        for (int a = 0; a < 2; ++a)
#pragma unroll
            for (int b = 0; b < 2; ++b)
#pragma unroll
                for (int m = 0; m < 4; ++m)
#pragma unroll
                    for (int n = 0; n < 2; ++n) acc[a][b][m][n] = (f32x4){0.f, 0.f, 0.f, 0.f};
        cur = nxt; cA = nA; cB0 = nB0; cB1 = nB1; ++ui;
        if (wr == 1) PG8_BAR;
    }
    PG8_WAIT_V(0);
    PG8_BAR;
#undef PG8_SA
#undef PG8_SB
#undef PG8_STAGE
#undef PG8_LDA
#undef PG8_LDB
#undef PG8_MMA
#undef PG8_WAIT_V
#undef PG8_WAIT_L
#undef PG8_BAR
#undef PG8_SCHED
}
}
struct Ptrs {
    const float *x_prompt, *x_sample, *cache_lat, *cache_krope, *state_gla, *cache_conv, *meta, *g_mix, *w_in, *w_a2, *b_a, *g_gla, *g_q, *w_uq, *g_kv, *w_uk, *w_uv, *w_o, *g_ffn, *w_up, *conv_w, *conv_b, *w_down, *final_norm;
    float* out; unsigned char* ws;
};
#define WSP(T, off) ((T*)(P.ws + (off)))

struct TileOrder {
    int nM, nN, nwg, G, c;
    __device__ __forceinline__ void init(int nM_, int nN_, int G_, int c_) { nM = nM_; nN = nN_; nwg = nM * nN; G = G_; c = c_; }
    __device__ __forceinline__ bool map(int i, int& pm, int& pn) const {
        const long L = (long)i * G + c; if (L >= nwg) return false;
        int wgid = (int)L; { const int q = nwg / 8, r = nwg % 8, xcd = wgid % 8, off = wgid / 8; wgid = (xcd < r ? xcd * (q + 1) : r * (q + 1) + (xcd - r) * q) + off; }
        const int nig = 8 * nN, gid = wgid / nig, fm = gid * 8, gsz = (nM - fm) < 8 ? (nM - fm) : 8;
        pm = fm + ((wgid % nig) % gsz); pn = (wgid % nig) / gsz; return true;
    }
};
struct SchedPlain {
    TileOrder o; const char* A; const char* Bt; size_t a_tile, b_tile;
    __device__ __forceinline__ bool next(int i, pg8::Unit& u) const { u.kind = 0; return o.map(i, u.pm, u.pn); }
    __device__ __forceinline__ const char* a_ptr(const pg8::Unit& u) const { return A + (size_t)u.pm * a_tile; }
    __device__ __forceinline__ const char* b_ptr(const pg8::Unit& u, int h) const { return Bt + (size_t)u.pn * b_tile + (size_t)h * (b_tile >> 1); }
};
struct SchedP2 {
    int G, c; const char* ws;
    __device__ __forceinline__ bool next(int i, pg8::Unit& u) const {
        int L = i * G + c;
        if (L < 420) { u.kind = 0; u.pm = L / 12; u.pn = L % 12; return true; } L -= 420;
        if (L < 528) { u.kind = 1; const int t = L >> 4; u.pm = t < 32 ? t : 34; u.pn = L & 15; return true; } L -= 528;
        if (L < 64) { u.kind = 2; u.pm = 32 + (L >> 5); u.pn = L & 31; return true; }
        return false;
    }
    __device__ __forceinline__ const char* a_ptr(const pg8::Unit& u) const { return ws + WS_H + ((size_t)u.pm * 256 * NH + (u.kind == 1 ? HC_CKV : HC_CQ)) * 2; }
    __device__ __forceinline__ const char* b_ptr(const pg8::Unit& u, int h) const { const size_t off = u.kind == 0 ? WS_WQT : (u.kind == 1 ? WS_WKVT : WS_WABS); return ws + off + ((size_t)u.pn * 256 + h * 128) * 512 * 2; }
};
struct SchedWabs {
    int G, c; const char* WUKN; const char* WUQN;
    __device__ __forceinline__ bool next(int i, pg8::Unit& u) const { const int L = i * G + c; if (L >= 64) return false; u.kind = 3 + (L >> 2); u.pm = (L >> 1) & 1; u.pn = L & 1; return true; }
    __device__ __forceinline__ const char* a_ptr(const pg8::Unit& u) const { return WUKN + ((size_t)u.pm * 256 * 2048 + (u.kind - 3) * 128) * 2; }
    __device__ __forceinline__ const char* b_ptr(const pg8::Unit& u, int h) const { return WUQN + (((size_t)u.pn * 256 + h * 128) * 3072 + (u.kind - 3) * 192) * 2; }
};

struct EpiInProj {
    static constexpr bool PERM = true;
    bf16_t* H; const float* rsx; float* ss;
    __device__ __forceinline__ void operator()(const pg8::Acc& acc, const pg8::Unit& u, int wr, int wc, int, int) const {
        const int lane_ = lane_now(), fr = lane_ & 15, fq = lane_ >> 4;
        const int row0 = u.pm * 256 + wr * 64 + fr, col0 = u.pn * 256 + wc * 32 + 8 * fq;
        const bool stats = (u.pn >= 24 && u.pn < 28);
#pragma unroll
        for (int ai = 0; ai < 2; ++ai)
#pragma unroll
            for (int m = 0; m < 4; ++m) {
                const int row = row0 + ai * 128 + m * 16; const float rs = rsx[row]; float sq = 0.f;
#pragma unroll
                for (int bj = 0; bj < 2; ++bj) { const f32x4 v0 = acc[ai][bj][m][0] * rs, v1 = acc[ai][bj][m][1] * rs;
                    sq += (v0[0] * v0[0] + v0[1] * v0[1]) + (v0[2] * v0[2] + v0[3] * v0[3]) + (v1[0] * v1[0] + v1[1] * v1[1]) + (v1[2] * v1[2] + v1[3] * v1[3]);
                    u32x4 w; w.x = pk2(v0[0], v0[1]); w.y = pk2(v0[2], v0[3]); w.z = pk2(v1[0], v1[1]); w.w = pk2(v1[2], v1[3]);
                    *(u32x4*)(H + (size_t)row * NH + col0 + bj * 128) = w; }
                if (stats) { sq += __shfl_xor(sq, 16); sq += __shfl_xor(sq, 32); if (fq == 0) ss[row * 16 + (u.pn - 24) * 4 + wc] = sq; }
            }
    }
};
struct EpiP2 {
    static constexpr bool PERM = true;
    bf16_t *Q, *KV, *QLAT, *WABS; const float* ss; const f32x2* rope;
    __device__ __forceinline__ void operator()(const pg8::Acc& acc, const pg8::Unit& u, int wr, int wc, int, int) const {
        const int lane_ = lane_now(), fr = lane_ & 15, fq = lane_ >> 4;
        const int rl0 = wr * 64 + fr, cl0 = wc * 32 + 8 * fq;
        bf16_t* dst; int ldc; int mode;
        if (u.kind == 0) { dst = Q + (size_t)u.pm * 256 * QP + u.pn * 256; ldc = QP; mode = 0; }
        else if (u.kind == 1) { dst = KV + (size_t)(u.pm < 32 ? u.pm : 32) * 256 * 4096 + u.pn * 256; ldc = 4096; mode = 1; }
        else if (u.kind == 2) { dst = QLAT + (size_t)(u.pm - 32) * 256 * 8192 + u.pn * 256; ldc = 8192; mode = 0; }
        else { dst = WABS + ((size_t)(u.kind - 3) * 512 + u.pm * 256) * 512 + u.pn * 256; ldc = 512; mode = 2; }
        const bool do_rope = (u.kind == 0 && u.pn >= 8);
#pragma unroll
        for (int ai = 0; ai < 2; ++ai)
#pragma unroll
            for (int m = 0; m < 4; ++m) {
                const int rl = rl0 + ai * 128 + m * 16, row = u.pm * 256 + rl; float sc = 1.f;
                if (mode != 2) { const f32x4* sp = (const f32x4*)(ss + row * 16 + (mode == 1 ? 8 : 0)); const f32x4 a = sp[0], b = sp[1];
                    sc = __builtin_amdgcn_rsqf(((a[0] + a[1]) + (a[2] + a[3]) + (b[0] + b[1]) + (b[2] + b[3])) * (1.f / 512.f) + EPS); if (mode == 0) sc *= QSCALE; }
#pragma unroll
                for (int bj = 0; bj < 2; ++bj) { f32x4 v0 = acc[ai][bj][m][0] * sc, v1 = acc[ai][bj][m][1] * sc;
                    if (do_rope) { const int i0 = ((u.pn * 256 + bj * 128 + cl0) & 63) >> 1; const f32x4* rp = (const f32x4*)(rope + (size_t)row * 32 + i0); const f32x4 c0 = rp[0], c1 = rp[1];
                        f32x4 t0, t1; t0[0] = v0[0] * c0[0] - v0[1] * c0[1]; t0[1] = v0[1] * c0[0] + v0[0] * c0[1]; t0[2] = v0[2] * c0[2] - v0[3] * c0[3]; t0[3] = v0[3] * c0[2] + v0[2] * c0[3];
                        t1[0] = v1[0] * c1[0] - v1[1] * c1[1]; t1[1] = v1[1] * c1[0] + v1[0] * c1[1]; t1[2] = v1[2] * c1[2] - v1[3] * c1[3]; t1[3] = v1[3] * c1[2] + v1[2] * c1[3]; v0 = t0; v1 = t1; }
                    u32x4 w; w.x = pk2(v0[0], v0[1]); w.y = pk2(v0[2], v0[3]); w.z = pk2(v1[0], v1[1]); w.w = pk2(v1[2], v1[3]);
                    *(u32x4*)(dst + (size_t)rl * ldc + bj * 128 + cl0) = w; }
            }
    }
};
struct EpiWabs {
    static constexpr bool PERM = true;
    bf16_t* WABS;
    __device__ __forceinline__ void operator()(const pg8::Acc& acc, const pg8::Unit& u, int wr, int wc, int, int) const {
        const int lane_ = lane_now(), fr = lane_ & 15, fq = lane_ >> 4;
        bf16_t* dst = WABS + ((size_t)(u.kind - 3) * 512 + u.pm * 256 + wr * 64 + fr) * 512 + u.pn * 256 + wc * 32 + 8 * fq;
#pragma unroll
        for (int ai = 0; ai < 2; ++ai)
#pragma unroll
            for (int m = 0; m < 4; ++m)
#pragma unroll
                for (int bj = 0; bj < 2; ++bj) { const f32x4 v0 = acc[ai][bj][m][0], v1 = acc[ai][bj][m][1];
                    u32x4 w; w.x = pk2(v0[0], v0[1]); w.y = pk2(v0[2], v0[3]); w.z = pk2(v1[0], v1[1]); w.w = pk2(v1[2], v1[3]);
                    *(u32x4*)(dst + (size_t)(ai * 128 + m * 16) * 512 + bj * 128) = w; }
    }
};
struct EpiOut {
    static constexpr bool PERM = false;
    const float *xp, *xs, *meta; float* dout; float* x2m; bf16_t* x2b; float* ss2;
    __device__ __forceinline__ void operator()(const pg8::Acc& acc, const pg8::Unit& u, int wr, int wc, int, int) const {
        const int lane_ = lane_now(), fr = lane_ & 15, fq = lane_ >> 4;
        const int rl0 = wr * 64 + fr, c0 = u.pn * 256 + wc * 32 + 4 * fq;
        const float* xb = u.pm < 32 ? xp + (size_t)u.pm * 256 * DM : (u.pm < 34 ? xs + (size_t)(u.pm - 32) * 256 * DM : meta);
        float* ob = u.pm < 34 ? dout + (size_t)u.pm * 256 * DM : x2m;
#pragma unroll
        for (int ai = 0; ai < 2; ++ai)
#pragma unroll
            for (int m = 0; m < 4; ++m) {
                const int rl = rl0 + ai * 128 + m * 16, row = u.pm * 256 + rl; const bool xv = (u.pm < 34) || (rl < 16); float sq = 0.f;
#pragma unroll
                for (int bj = 0; bj < 2; ++bj)
#pragma unroll
                    for (int n = 0; n < 2; ++n) { const int c = c0 + bj * 128 + n * 16;
                        f32x4 xx = (f32x4){0.f, 0.f, 0.f, 0.f}; if (xv) xx = *(const f32x4*)(xb + (size_t)rl * DM + c);
                        const f32x4 v = xx + acc[ai][bj][m][n];
                        sq += (v[0] * v[0] + v[1] * v[1]) + (v[2] * v[2] + v[3] * v[3]);
                        *(f32x4*)(ob + (size_t)rl * DM + c) = v;
                        u32x2 w; w.x = pk2(v[0], v[1]); w.y = pk2(v[2], v[3]); *(u32x2*)(x2b + (size_t)row * DM + c) = w; }
                sq += __shfl_xor(sq, 16); sq += __shfl_xor(sq, 32); if (fq == 0) ss2[row * 32 + u.pn * 4 + wc] = sq;
            }
    }
};
struct EpiUp {
    static constexpr bool PERM = true;
    bf16_t* U;
    __device__ __forceinline__ void operator()(const pg8::Acc& acc, const pg8::Unit& u, int wr, int wc, int, int) const {
        const int lane_ = lane_now(), fr = lane_ & 15, fq = lane_ >> 4;
        const int row0 = u.pm * 256 + wr * 64 + fr, col0 = u.pn * 256 + wc * 32 + 8 * fq;
#pragma unroll
        for (int ai = 0; ai < 2; ++ai)
#pragma unroll
            for (int m = 0; m < 4; ++m) { const int row = row0 + ai * 128 + m * 16;
#pragma unroll
                for (int bj = 0; bj < 2; ++bj) { const f32x4 v0 = acc[ai][bj][m][0], v1 = acc[ai][bj][m][1];
                    u32x4 w; w.x = pk2(v0[0], v0[1]); w.y = pk2(v0[2], v0[3]); w.z = pk2(v1[0], v1[1]); w.w = pk2(v1[2], v1[3]);
                    *(u32x4*)(U + (size_t)row * DFF2 + col0 + bj * 128) = w; } }
    }
};
struct EpiDown {
    static constexpr bool PERM = false;
    float* dout;
    __device__ __forceinline__ void operator()(const pg8::Acc& acc, const pg8::Unit& u, int wr, int wc, int, int) const {
        const int lane_ = lane_now(), fr = lane_ & 15, fq = lane_ >> 4;
        const int row0 = u.pm * 256 + wr * 64 + fr, c0 = u.pn * 256 + wc * 32 + 4 * fq;
#pragma unroll
        for (int ai = 0; ai < 2; ++ai)
#pragma unroll
            for (int m = 0; m < 4; ++m) { const int row = row0 + ai * 128 + m * 16;
#pragma unroll
                for (int bj = 0; bj < 2; ++bj)
#pragma unroll
                    for (int n = 0; n < 2; ++n) { float* p = dout + (size_t)row * DM + c0 + bj * 128 + n * 16; *(f32x4*)p = *(const f32x4*)p + acc[ai][bj][m][n]; } }
    }
};
struct WaveCtx { LAS unsigned char* lds; int wave, gw, ngw; };

#define LDS_WAIT() asm volatile("s_waitcnt lgkmcnt(0)" ::: "memory")
template <class ColMap>
__device__ __forceinline__ void transpose_item(const float* W, int K, int Nsrc, const float* gain, bf16_t* WT, LAS float* scr, int item, int nblk, int lane, const ColMap& cm) {
    const int kb = item / nblk, nb = item % nblk, k0 = 64 * kb, n0 = 32 * nb;
    const int sc = cm(n0 + (lane & 31));
#pragma unroll 8
    for (int i = 0; i < 32; ++i) { const int kk = 2 * i + (lane >> 5); float v = 0.f; if (sc >= 0) { v = W[(size_t)(k0 + kk) * Nsrc + sc]; if (gain) v *= gain[k0 + kk]; } scr[kk * 33 + (lane & 31)] = v; }
    LDS_WAIT(); asm volatile("" ::: "memory");
    const int c = lane & 7;
#pragma unroll
    for (int j = 0; j < 4; ++j) { const int n = (lane >> 3) + 8 * j; const LAS float* s = scr + (8 * c) * 33 + n;
        u32x4 o; o.x = pk2(s[0 * 33], s[1 * 33]); o.y = pk2(s[2 * 33], s[3 * 33]); o.z = pk2(s[4 * 33], s[5 * 33]); o.w = pk2(s[6 * 33], s[7 * 33]);
        *(u32x4*)(WT + (size_t)(n0 + n) * K + k0 + 8 * c) = o; }
    LDS_WAIT(); asm volatile("" ::: "memory");
}
struct MapIn {
    __device__ __forceinline__ int operator()(int n) const {
        if (n < 6144) return n;
        if (n < 6656) return 6160 + (n - 6144);
        if (n < 7168) return 6672 + (n - 6656);
        if (n < 9216) return 7248 + (n - 7168);
        if (n < 11264) return 9296 + (n - 9216);
        if (n < 11328) { const int j = n - 11264, i = j >> 1; return 7184 + ((j & 1) ? i + 32 : i); }
        if (n < 11344) return 6144 + (n - 11328);
        return -1; }
};
struct MapQ {
    __device__ __forceinline__ int operator()(int n) const {
        if (n < 2048) return (n >> 7) * 192 + (n & 127);
        const int j = n - 2048, h = j >> 6, jj = j & 63, i = jj >> 1; return h * 192 + 128 + ((jj & 1) ? i + 32 : i); }
};
struct MapId { __device__ __forceinline__ int operator()(int n) const { return n; } };
struct MapOff { int off; __device__ __forceinline__ int operator()(int n) const { return n - off; } };

__device__ __forceinline__ void load8bf(const bf16_t* p, float (&v)[8]) { const u32x4 w = *(const u32x4*)p; v[0] = bflo(w.x); v[1] = bfhi(w.x); v[2] = bflo(w.y); v[3] = bfhi(w.y); v[4] = bflo(w.z); v[5] = bfhi(w.z); v[6] = bflo(w.w); v[7] = bfhi(w.w); }
__device__ __forceinline__ u32x4 pack8(const float (&v)[8]) { u32x4 w; w.x = pk2(v[0], v[1]); w.y = pk2(v[2], v[3]); w.z = pk2(v[4], v[5]); w.w = pk2(v[6], v[7]); return w; }

__device__ __forceinline__ void p0_prologue(const Ptrs& P, const WaveCtx& C) {
    const int lane = lane_now();
    LAS float* scr = (LAS float*)(C.lds + C.wave * 16384);
    constexpr int I_IN = 32 * 360, I_Q = 8 * 96, I_KV = 8 * 64, I_O = 32 * 64, I_UV = 8 * 64;
    constexpr int NITEMS = I_IN + I_Q + 2 * I_KV + I_O + I_UV;
    for (int it = C.gw; it < NITEMS; it += C.ngw) {
        int r = it;
        if (r < I_IN) { transpose_item(P.w_in, DM, IN_COLS, P.g_mix, WSP(bf16_t, WS_W1T), scr, r, 360, lane, MapIn()); continue; } r -= I_IN;
        if (r < I_Q) { transpose_item(P.w_uq, 512, 3072, P.g_q, WSP(bf16_t, WS_WQT), scr, r, 96, lane, MapQ()); continue; } r -= I_Q;
        if (r < I_KV) { transpose_item(P.w_uk, 512, 2048, P.g_kv, WSP(bf16_t, WS_WKVT), scr, r, 64, lane, MapId()); continue; } r -= I_KV;
        if (r < I_KV) { transpose_item(P.w_uv, 512, 2048, P.g_kv, WSP(bf16_t, WS_WKVT) + (size_t)2048 * 512, scr, r, 64, lane, MapId()); continue; } r -= I_KV;
        if (r < I_O) { transpose_item(P.w_o, DM, DM, nullptr, WSP(bf16_t, WS_WOT), scr, r, 64, lane, MapId()); continue; } r -= I_O;
        transpose_item(P.w_uv, 512, 2048, nullptr, WSP(bf16_t, WS_WUVT), scr, r, 64, lane, MapId());
    }
    { const int nth = C.ngw * 64, t0 = C.gw * 64 + lane;
      for (int i = t0; i < 512 * 2048 / 4; i += nth) { const f32x4 v = *(const f32x4*)(P.w_uk + (size_t)i * 4); u32x2 w; w.x = pk2(v[0], v[1]); w.y = pk2(v[2], v[3]); *(u32x2*)(WSP(bf16_t, WS_WUKN) + (size_t)i * 4) = w; }
      for (int i = t0; i < 512 * 3072 / 4; i += nth) { const f32x4 v = *(const f32x4*)(P.w_uq + (size_t)i * 4) * P.g_q[(i * 4) / 3072]; u32x2 w; w.x = pk2(v[0], v[1]); w.y = pk2(v[2], v[3]); *(u32x2*)(WSP(bf16_t, WS_WUQN) + (size_t)i * 4) = w; } }
    for (int row = C.gw; row < M_PAD; row += C.ngw) {
        const float* src = row < R_SAMPLE ? P.x_prompt + (size_t)row * DM : (row < R_META ? P.x_sample + (size_t)(row - R_SAMPLE) * DM : (row < M_REAL ? P.meta + (size_t)(row - R_META) * DM : nullptr));
        bf16_t* dst = WSP(bf16_t, WS_XBF) + (size_t)row * DM;
        if (src) { f32x4 v[8]; float s = 0.f;
#pragma unroll
            for (int j = 0; j < 8; ++j) { v[j] = *(const f32x4*)(src + (j * 64 + lane) * 4); s += (v[j][0] * v[j][0] + v[j][1] * v[j][1]) + (v[j][2] * v[j][2] + v[j][3] * v[j][3]); }
            s = wave_sum(s);
#pragma unroll
            for (int j = 0; j < 8; ++j) { u32x2 w; w.x = pk2(v[j][0], v[j][1]); w.y = pk2(v[j][2], v[j][3]); *(u32x2*)(dst + (j * 64 + lane) * 4) = w; }
            if (lane == 0) WSP(float, WS_RSX)[row] = __builtin_amdgcn_rsqf(s * (1.f / DM) + EPS);
        } else {
#pragma unroll
            for (int j = 0; j < 8; ++j) *(u32x2*)(dst + (j * 64 + lane) * 4) = (u32x2){0u, 0u};
            if (lane == 0) WSP(float, WS_RSX)[row] = 0.f;
        }
        if (lane < 32) { const int pos = row < R_SAMPLE ? row + N_META : (row < R_META ? PAST + ((row - R_SAMPLE) & 15) : (row < M_REAL ? row - R_META : 0));
            double inv = 1.0; for (int k = 0; k < lane; ++k) inv *= 0.74989420933245582730;
            const double ang = (double)pos * inv, qd = __builtin_rint(ang * 0.63661977236758134308), r = (ang - qd * 1.57079632679489655800) - qd * 6.12323399573676603587e-17, r2 = r * r;
            const double sn = r * (1.0 + r2 * (-1.0 / 6 + r2 * (1.0 / 120 + r2 * (-1.0 / 5040 + r2 * (1.0 / 362880 + r2 * (-1.0 / 39916800 + r2 * (1.0 / 6227020800.0)))))));
            const double cs = 1.0 + r2 * (-0.5 + r2 * (1.0 / 24 + r2 * (-1.0 / 720 + r2 * (1.0 / 40320 + r2 * (-1.0 / 3628800 + r2 * (1.0 / 479001600.0 + r2 * (-1.0 / 87178291200.0)))))));
            const int qi = ((int)qd) & 3; const double sv = (qi == 0) ? sn : (qi == 1) ? cs : (qi == 2) ? -sn : -cs, cv = (qi == 0) ? cs : (qi == 1) ? -sn : (qi == 2) ? -cs : sn;
            WSP(f32x2, WS_ROPE)[(size_t)row * 32 + lane] = (f32x2){(float)cv, (float)sv}; }
    }
}

__device__ __forceinline__ void p1_wabs(const Ptrs& P, const WaveCtx& C) {
    const int lane = lane_now(), r32 = lane & 31, hi = lane >> 5;
    const bf16_t* A = WSP(bf16_t, WS_WUKN); const bf16_t* B = WSP(bf16_t, WS_WUQN); bf16_t* W = WSP(bf16_t, WS_WABS);
    for (int it = C.gw; it < 4096; it += C.ngw) { const int h = it >> 8, jb = (it >> 4) & 15, kb = it & 15;
        const bf16_t* ap = A + (size_t)(32 * jb + r32) * 2048 + h * 128 + 8 * hi; const bf16_t* bp = B + (size_t)(32 * kb + r32) * 3072 + h * 192 + 8 * hi;
        f32x16 c = (f32x16){0.f, 0.f, 0.f, 0.f, 0.f, 0.f, 0.f, 0.f, 0.f, 0.f, 0.f, 0.f, 0.f, 0.f, 0.f, 0.f};
#pragma unroll
        for (int ks = 0; ks < 8; ++ks) c = MFMA32(*(const bf16x8*)(ap + 16 * ks), *(const bf16x8*)(bp + 16 * ks), c);
        bf16_t* wp = W + ((size_t)h * 512 + 32 * jb + 4 * hi) * 512 + 32 * kb + r32;
#pragma unroll
        for (int r = 0; r < 16; ++r) wp[(size_t)((r & 3) + 8 * (r >> 2)) * 512] = f2bf(c[r]); }
}

__device__ __forceinline__ float log_alpha(const float (&wa)[16], float ba, const bf16_t* ag) {
    float a[8], b[8]; load8bf(ag, a); load8bf(ag + 8, b); float z = ba;
#pragma unroll
    for (int k = 0; k < 8; ++k) z = fmaf(a[k], wa[k], z);
#pragma unroll
    for (int k = 0; k < 8; ++k) z = fmaf(b[k], wa[8 + k], z);
    const float ls = fminf(z, 0.f) - log1pf(__expf(-fabsf(z)));
    return fmaxf(ls * (1.f / 16.f), -5.f);
}
__device__ __forceinline__ void p2_rows(const Ptrs& P, const WaveCtx& C) {
    const int lane = lane_now();
    bf16_t* H = WSP(bf16_t, WS_H);
    for (int row = C.gw; row < M_REAL; row += C.ngw) {
        const int srow = row - R_SAMPLE; const bool is_s = (row >= R_SAMPLE && row < R_META);
        const int opos = row < R_SAMPLE ? row + N_META : (is_s ? srow : row - R_META);
        float c[8]; load8bf(H + (size_t)row * NH + HC_CKV + 8 * lane, c); float s = 0.f;
#pragma unroll
        for (int j = 0; j < 8; ++j) s += c[j] * c[j];
        const float rs = __builtin_amdgcn_rsqf(wave_sum(s) * (1.f / 512.f) + EPS);
        const f32x4 g0 = *(const f32x4*)(P.g_kv + 8 * lane), g1 = *(const f32x4*)(P.g_kv + 8 * lane + 4);
        float l[8];
#pragma unroll
        for (int j = 0; j < 8; ++j) l[j] = c[j] * rs * (j < 4 ? g0[j] : g1[j - 4]);
        float* lo = P.out + (is_s ? O_LATS : O_LATP) + (size_t)opos * 512 + 8 * lane;
        *(f32x4*)lo = (f32x4){l[0], l[1], l[2], l[3]}; *(f32x4*)(lo + 4) = (f32x4){l[4], l[5], l[6], l[7]};
        if (is_s) *(u32x4*)(WSP(bf16_t, WS_SKL) + ((size_t)(srow >> 4) * TK_S + PAST + (srow & 15)) * 512 + 8 * lane) = pack8(l);
        if (lane < 32) { const unsigned w = *(const unsigned*)(H + (size_t)row * NH + HC_KPE + 2 * lane); const float x1 = bflo(w), x2 = bfhi(w);
            const f32x2 cs = WSP(f32x2, WS_ROPE)[(size_t)row * 32 + lane]; const float o1 = x1 * cs.x - x2 * cs.y, o2 = x2 * cs.x + x1 * cs.y;
            float* ko = P.out + (is_s ? O_KRS : O_KRP) + (size_t)opos * 64; ko[lane] = o1; ko[lane + 32] = o2;
            const unsigned pw = pk2(o1, o2); *(unsigned*)(WSP(bf16_t, WS_KPE) + (size_t)row * 64 + 2 * lane) = pw;
            if (is_s) *(unsigned*)(WSP(bf16_t, WS_SKP) + ((size_t)(srow >> 4) * TK_S + PAST + (srow & 15)) * 64 + 2 * lane) = pw; }
    }
    for (int it = C.gw; it < DEC_B * PAST; it += C.ngw) { const int b = it >> 10, p = it & 1023;
        const float* ls = P.cache_lat + (size_t)it * 512 + 8 * lane; const f32x4 a = *(const f32x4*)ls, bb = *(const f32x4*)(ls + 4);
        u32x4 w; w.x = pk2(a[0], a[1]); w.y = pk2(a[2], a[3]); w.z = pk2(bb[0], bb[1]); w.w = pk2(bb[2], bb[3]);
        *(u32x4*)(WSP(bf16_t, WS_SKL) + ((size_t)b * TK_S + p) * 512 + 8 * lane) = w;
        if (lane < 32) { const float* ks = P.cache_krope + (size_t)it * 64; *(unsigned*)(WSP(bf16_t, WS_SKP) + ((size_t)b * TK_S + p) * 64 + 2 * lane) = pk2(ks[lane], ks[lane + 32]); } }
    for (int it = C.gw; it < 137 * 16; it += C.ngw) { const int j = it >> 4, cb = it & 15, col = cb * 64 + lane, h = cb >> 2, dk = col & 255; const bool is_s = (j >= 128 && j < 136);
        float wa[16];
#pragma unroll
        for (int k = 0; k < 16; ++k) wa[k] = P.w_a2[k * 1024 + col];
        const float ba = P.b_a[col]; const int row0 = 64 * j;
        float bl[4] = {0.f, 0.f, 0.f, 0.f};
#pragma unroll
        for (int sub = 0; sub < 4; ++sub) { float s = 0.f;
            for (int r = 0; r < 16; ++r) { const int row = row0 + sub * 16 + r; const float la = row < M_REAL ? log_alpha(wa, ba, H + (size_t)row * NH + HC_AG) : 0.f; s += la; }
            bl[sub] = s; }
        if (!is_s) { const float t = (bl[0] + bl[1]) + (bl[2] + bl[3]); bl[0] = bl[1] = bl[2] = bl[3] = t; WSP(float, WS_DECP)[j * 1024 + col] = __expf(t); }
        else {
#pragma unroll
            for (int sub = 0; sub < 4; ++sub) WSP(float, WS_DECS)[(4 * (j - 128) + sub) * 1024 + col] = __expf(bl[sub]); }
        float bc = 0.f; bf16_t* ket = WSP(bf16_t, WS_KET) + ((size_t)(j * 4 + h) * 256 + dk) * 64;
#pragma unroll
        for (int sub = 0; sub < 4; ++sub) { const float blast = bl[sub]; if (is_s) bc = 0.f;
            for (int r8 = 2 * sub; r8 < 2 * sub + 2; ++r8) { float ke[8];
#pragma unroll
                for (int rr = 0; rr < 8; ++rr) { const int row = row0 + r8 * 8 + rr; bf16_t* hp = H + (size_t)row * NH;
                    const float la = row < M_REAL ? log_alpha(wa, ba, hp + HC_AG) : 0.f; bc += la;
                    const float q = bf1(hp[HC_Q + col]), k = bf1(hp[HC_K + col]);
                    hp[HC_Q + col] = f2bf(q * __expf(bc) * (1.f / 16.f)); hp[HC_K + col] = f2bf(k * __expf(-bc)); ke[rr] = k * __expf(blast - bc); }
                *(u32x4*)(ket + r8 * 8) = pack8(ke); } }
    }
}

__device__ __forceinline__ void p4_merge(const Ptrs& P, const WaveCtx& C) {
    const int lane = lane_now();
    const bf16_t* H = WSP(bf16_t, WS_H); const bf16_t* Q = WSP(bf16_t, WS_Q); bf16_t* MG = WSP(bf16_t, WS_MERGED);
    for (int row = C.gw; row < M_REAL; row += C.ngw) { const bf16_t* hp = H + (size_t)row * NH;
        const f32x4 g0 = *(const f32x4*)(P.g_gla + 8 * lane), g1 = *(const f32x4*)(P.g_gla + 8 * lane + 4);
#pragma unroll
        for (int h = 0; h < 4; ++h) { const int cc = h * 512 + 8 * lane;
            float og[8], r[8], ga[8], gb[8], om[8], o[8]; load8bf(hp + HC_V + cc, og); load8bf(hp + HC_R + cc, r); load8bf(hp + HC_GA + cc, ga); load8bf(hp + HC_GB + cc, gb); load8bf(Q + (size_t)row * QP + cc, om);
            float s = 0.f;
#pragma unroll
            for (int j = 0; j < 8; ++j) s += og[j] * og[j];
            const float rs = __builtin_amdgcn_rsqf(wave_sum(s) * (1.f / 512.f) + EPS);
#pragma unroll
            for (int j = 0; j < 8; ++j) o[j] = sigmoidf_(ga[j]) * (og[j] * rs * (j < 4 ? g0[j] : g1[j - 4])) * (r[j] * sigmoidf_(r[j])) + sigmoidf_(gb[j]) * om[j];
            *(u32x4*)(MG + (size_t)row * DM + cc) = pack8(o); }
    }
    LAS float* scr = (LAS float*)(C.lds + C.wave * 16384);
    constexpr int I_UP = 32 * 352, I_DN = 88 * 64;
    for (int it = C.gw; it < I_UP + I_DN; it += C.ngw) {
        if (it < I_UP) transpose_item(P.w_up, DM, DFF2, P.g_ffn, WSP(bf16_t, WS_WUPT), scr, it, 352, lane, MapId());
        else transpose_item(P.w_down, DFF, DM, nullptr, WSP(bf16_t, WS_WDT), scr, it - I_UP, 64, lane, MapId());
    }
}

__device__ __forceinline__ float rs2_of(const float* ss2, int row, int lane) { float v = lane < 32 ? ss2[row * 32 + lane] : 0.f; return __builtin_amdgcn_rsqf(wave_sum(v) * (1.f / DM) + EPS); }
__device__ __forceinline__ void p7_conv(const Ptrs& P, const WaveCtx& C) {
    const int lane = lane_now();
    const bf16_t* U = WSP(bf16_t, WS_H); bf16_t* GT = WSP(bf16_t, WS_GATE); const float* ss2 = WSP(float, WS_SS2);
    for (int row = C.gw; row < R_META; row += C.ngw) {
        int p1, p2; const float *h1 = nullptr, *h2 = nullptr; float* cvo = nullptr;
        if (row < R_SAMPLE) { p1 = row >= 1 ? row - 1 : R_META + 15; p2 = row >= 2 ? row - 2 : R_META + 14 + row; if (row >= T_P - 2) cvo = P.out + O_CVP + (size_t)(row - (T_P - 2)) * DFF2; }
        else { const int sr = row - R_SAMPLE, b = sr >> 4, t = sr & 15; const float* hist = P.cache_conv + (size_t)b * 2 * DFF2;
            p1 = t >= 1 ? row - 1 : -1; p2 = t >= 2 ? row - 2 : -1; if (t == 0) { h1 = hist + DFF2; h2 = hist; } else if (t == 1) { h2 = hist + DFF2; }
            if (t >= 14) cvo = P.out + O_CVS + (size_t)(b * 2 + (t - 14)) * DFF2; }
        const float rs0 = rs2_of(ss2, row, lane), rs1 = p1 >= 0 ? rs2_of(ss2, p1, lane) : 1.f, rs2 = p2 >= 0 ? rs2_of(ss2, p2, lane) : 1.f;
        for (int it = 0; it < 11; ++it) { const int n = (it * 64 + lane) * 8; float cv[2][8];
#pragma unroll
            for (int hf = 0; hf < 2; ++hf) { const int nn = n + hf * DFF; float uc[8], u1[8], u2[8];
                load8bf(U + (size_t)row * DFF2 + nn, uc);
                if (p1 >= 0) load8bf(U + (size_t)p1 * DFF2 + nn, u1); else { const f32x4 a = *(const f32x4*)(h1 + nn), b = *(const f32x4*)(h1 + nn + 4); u1[0] = a[0]; u1[1] = a[1]; u1[2] = a[2]; u1[3] = a[3]; u1[4] = b[0]; u1[5] = b[1]; u1[6] = b[2]; u1[7] = b[3]; }
                if (p2 >= 0) load8bf(U + (size_t)p2 * DFF2 + nn, u2); else { const f32x4 a = *(const f32x4*)(h2 + nn), b = *(const f32x4*)(h2 + nn + 4); u2[0] = a[0]; u2[1] = a[1]; u2[2] = a[2]; u2[3] = a[3]; u2[4] = b[0]; u2[5] = b[1]; u2[6] = b[2]; u2[7] = b[3]; }
                const float* cw = P.conv_w + nn; const float* cb = P.conv_b + nn;
#pragma unroll
                for (int j = 0; j < 8; ++j) { const float c0 = uc[j] * rs0; uc[j] = c0; cv[hf][j] = cb[j] + cw[j] * (u2[j] * rs2) + cw[DFF2 + j] * (u1[j] * rs1) + cw[2 * DFF2 + j] * c0; }
                if (cvo) { *(f32x4*)(cvo + nn) = (f32x4){uc[0], uc[1], uc[2], uc[3]}; *(f32x4*)(cvo + nn + 4) = (f32x4){uc[4], uc[5], uc[6], uc[7]}; } }
            float g[8];
#pragma unroll
            for (int j = 0; j < 8; ++j) g[j] = cv[0][j] * sigmoidf_(cv[0][j]) * cv[1][j];
            *(u32x4*)(GT + (size_t)row * DFF + n) = pack8(g); }
    }
}

__device__ __forceinline__ void p9_final(const Ptrs& P, const WaveCtx& C) {
    const int lane = lane_now();
    for (int row = C.gw; row < R_META; row += C.ngw) { float* xr = P.out + (size_t)row * DM; f32x4 v[8]; float s = 0.f;
#pragma unroll
        for (int j = 0; j < 8; ++j) { v[j] = *(const f32x4*)(xr + (j * 64 + lane) * 4); s += (v[j][0] * v[j][0] + v[j][1] * v[j][1]) + (v[j][2] * v[j][2] + v[j][3] * v[j][3]); }
        const float rs = __builtin_amdgcn_rsqf(wave_sum(s) * (1.f / DM) + EPS);
#pragma unroll
        for (int j = 0; j < 8; ++j) { const f32x4 g = *(const f32x4*)(P.final_norm + (j * 64 + lane) * 4); *(f32x4*)(xr + (j * 64 + lane) * 4) = v[j] * rs * g; }
    }
}
__device__ __forceinline__ int crow(int r, int hi) { return (r & 3) + 8 * (r >> 2) + 4 * hi; }
__device__ __forceinline__ float hswap_max(float v) { auto rr = __builtin_amdgcn_permlane32_swap(__float_as_uint(v), __float_as_uint(v), false, false); return fmaxf(__uint_as_float(rr[0]), __uint_as_float(rr[1])); }
__device__ __forceinline__ float hswap_sum(float v) { auto rr = __builtin_amdgcn_permlane32_swap(__float_as_uint(v), __float_as_uint(v), false, false); return __uint_as_float(rr[0]) + __uint_as_float(rr[1]); }

constexpr int AT_KN = 16384, AT_KP = 8192, AT_VP = 320, AT_V = 64 * AT_VP, AT_BUF = AT_KN + AT_KP + AT_V;
__device__ __forceinline__ void attn_prompt_unit(const Ptrs& P, LAS unsigned char* lds, const int wid, int h, int qrow0, int nprompt, int tlim0) {
    const int lane = lane_now(), tid = wid * 64 + lane, r32 = lane & 31, hi = lane >> 5;
    bf16_t* Q = WSP(bf16_t, WS_Q); const bf16_t* KV = WSP(bf16_t, WS_KV); const bf16_t* KPE = WSP(bf16_t, WS_KPE);
    const int NT = nprompt + 1, tlim = tlim0 + (wid >> 1);
    bf16x8 qn[8], qp[4];
    { const bf16_t* qrow = Q + (size_t)(qrow0 + wid * 32 + r32) * QP;
#pragma unroll
      for (int ks = 0; ks < 8; ++ks) qn[ks] = *(const bf16x8*)(qrow + h * 128 + ks * 16 + hi * 8);
#pragma unroll
      for (int ks = 0; ks < 4; ++ks) qp[ks] = *(const bf16x8*)(qrow + 2048 + h * 64 + ks * 16 + hi * 8); }
    const int kn_r = tid >> 4, kn_c = tid & 15;
    const int kp_r = tid >> 3, kp_c = tid & 7;
    u32x4 sKn0, sKn1, sV0, sV1, sKp;
#define AT_LOAD(t) do { const int kvr = (t) == 0 ? 32 * 256 : ((t) - 1) * 64; const int kpr = (t) == 0 ? R_META : ((t) - 1) * 64; \
        const bf16_t* kb = KV + (size_t)(kvr + kn_r) * 4096 + h * 128 + kn_c * 8; \
        sKn0 = *(const u32x4*)kb; sKn1 = *(const u32x4*)(kb + (size_t)32 * 4096); sV0 = *(const u32x4*)(kb + 2048); sV1 = *(const u32x4*)(kb + (size_t)32 * 4096 + 2048); \
        sKp = *(const u32x4*)(KPE + (size_t)(kpr + kp_r) * 64 + kp_c * 8); } while (0)
#define AT_WRITE(buf) do { LAS unsigned char* bb = lds + (buf) * AT_BUF; \
        *(LAS u32x4*)(bb + kn_r * 256 + ((kn_c * 16) ^ ((kn_r & 7) << 4))) = sKn0; *(LAS u32x4*)(bb + (kn_r + 32) * 256 + ((kn_c * 16) ^ ((kn_r & 7) << 4))) = sKn1; \
        *(LAS u32x4*)(bb + AT_KN + kp_r * 128 + ((kp_c * 16) ^ ((kp_r & 7) << 4))) = sKp; \
        *(LAS u32x4*)(bb + AT_KN + AT_KP + kn_r * AT_VP + kn_c * 16) = sV0; *(LAS u32x4*)(bb + AT_KN + AT_KP + (kn_r + 32) * AT_VP + kn_c * 16) = sV1; } while (0)
    f32x16 o[4]; for (int d = 0; d < 4; ++d) o[d] = (f32x16){0.f, 0.f, 0.f, 0.f, 0.f, 0.f, 0.f, 0.f, 0.f, 0.f, 0.f, 0.f, 0.f, 0.f, 0.f, 0.f};
    float m_run = -1e30f, l_run = 0.f;
    const int vbase = (4 * (lane >> 5) + ((lane & 15) >> 2)) * AT_VP + (16 * ((lane >> 4) & 1) + 4 * (lane & 3)) * 2;
    AT_LOAD(0); AT_WRITE(0); __syncthreads();
    for (int t = 0; t < NT; ++t) {
        const int buf = t & 1;
        if (t + 1 < NT) AT_LOAD(t + 1);
        if (t == 0 || (t - 1) <= tlim) {
            LAS const unsigned char* bb = lds + buf * AT_BUF;
            f32x16 p[2];
#pragma unroll
            for (int kb = 0; kb < 2; ++kb) { p[kb] = (f32x16){0.f, 0.f, 0.f, 0.f, 0.f, 0.f, 0.f, 0.f, 0.f, 0.f, 0.f, 0.f, 0.f, 0.f, 0.f, 0.f}; const int row = 32 * kb + r32;
#pragma unroll
                for (int ks = 0; ks < 8; ++ks) { const bf16x8 a = *(LAS const bf16x8*)(bb + row * 256 + ((ks * 32 + hi * 16) ^ ((row & 7) << 4))); p[kb] = MFMA32(a, qn[ks], p[kb]); }
#pragma unroll
                for (int ks = 0; ks < 4; ++ks) { const bf16x8 a = *(LAS const bf16x8*)(bb + AT_KN + row * 128 + ((ks * 32 + hi * 16) ^ ((row & 7) << 4))); p[kb] = MFMA32(a, qp[ks], p[kb]); } }
            if (t == 0) {
#pragma unroll
                for (int r = 0; r < 16; ++r) { if (crow(r, hi) >= N_META) p[0][r] = -INFINITY; p[1][r] = -INFINITY; } }
            float mx = p[0][0];
#pragma unroll
            for (int r = 1; r < 16; ++r) mx = fmaxf(mx, p[0][r]);
#pragma unroll
            for (int r = 0; r < 16; ++r) mx = fmaxf(mx, p[1][r]);
            mx = hswap_max(mx);
            const float m_new = fmaxf(m_run, mx), alpha = __builtin_amdgcn_exp2f(m_run - m_new); m_run = m_new;
            float ps = 0.f;
#pragma unroll
            for (int kb = 0; kb < 2; ++kb)
#pragma unroll
                for (int r = 0; r < 16; ++r) { p[kb][r] = __builtin_amdgcn_exp2f(p[kb][r] - m_new); ps += p[kb][r]; }
            l_run = l_run * alpha + ps;
#pragma unroll
            for (int d = 0; d < 4; ++d)
#pragma unroll
                for (int r = 0; r < 16; ++r) o[d][r] *= alpha;
            LAS const unsigned char* vb = bb + AT_KN + AT_KP + vbase;
#pragma unroll
            for (int kb = 0; kb < 2; ++kb)
#pragma unroll
                for (int s = 0; s < 2; ++s) {
                    u32x4 pw; pw.x = pk2(p[kb][8 * s + 0], p[kb][8 * s + 1]); pw.y = pk2(p[kb][8 * s + 2], p[kb][8 * s + 3]); pw.z = pk2(p[kb][8 * s + 4], p[kb][8 * s + 5]); pw.w = pk2(p[kb][8 * s + 6], p[kb][8 * s + 7]);
                    const bf16x8 pf = __builtin_bit_cast(bf16x8, pw);
#pragma unroll
                    for (int d = 0; d < 4; ++d) { const s16x4 lo = lds_tr(vb + (32 * kb + 16 * s) * AT_VP + 64 * d), hh = lds_tr(vb + (32 * kb + 16 * s + 8) * AT_VP + 64 * d);
                        o[d] = MFMA32(cat8(lo, hh), pf, o[d]); } }
        }
        __syncthreads();
        if (t + 1 < NT) { AT_WRITE(buf ^ 1); }
        __syncthreads();
    }
    const float inv = 1.f / hswap_sum(l_run);
    bf16_t* orow = Q + (size_t)(qrow0 + wid * 32 + r32) * QP + h * 128;
#pragma unroll
    for (int d = 0; d < 4; ++d)
#pragma unroll
        for (int g = 0; g < 4; ++g) { u32x2 w; w.x = pk2(o[d][4 * g] * inv, o[d][4 * g + 1] * inv); w.y = pk2(o[d][4 * g + 2] * inv, o[d][4 * g + 3] * inv);
            *(u32x2*)(orow + 32 * d + 8 * g + 4 * hi) = w; }
#undef AT_LOAD
#undef AT_WRITE
}

constexpr int SA_P = 1168, SA_BUF = 32 * SA_P;
__device__ __forceinline__ void attn_sample_unit(const Ptrs& P, LAS unsigned char* lds, const int wid, int b, int hq) {
    const int lane = lane_now(), tid = wid * 64 + lane, l15 = lane & 15, g = lane >> 4;
    const int head = hq * 4 + (wid & 3), dvh = wid >> 2;
    bf16_t* Q = WSP(bf16_t, WS_Q); const bf16_t* QL = WSP(bf16_t, WS_QLAT); const bf16_t* SKL = WSP(bf16_t, WS_SKL) + (size_t)b * TK_S * 512; const bf16_t* SKP = WSP(bf16_t, WS_SKP) + (size_t)b * TK_S * 64;
    bf16x8 qf[18];
    { const bf16_t* ql = QL + (size_t)(b * 16 + l15) * 8192 + head * 512 + 8 * g; const bf16_t* qpe = Q + (size_t)(R_SAMPLE + b * 16 + l15) * QP + 2048 + head * 64 + 8 * g;
#pragma unroll
      for (int ks = 0; ks < 16; ++ks) qf[ks] = *(const bf16x8*)(ql + ks * 32);
      qf[16] = *(const bf16x8*)qpe; qf[17] = *(const bf16x8*)(qpe + 32); }
    constexpr int NT = 33, NCH = 32 * 72;
    u32x4 st[5];
#define SA_LOAD(t) do { _Pragma("unroll") for (int i = 0; i < 5; ++i) { const int idx = tid + i * 512; st[i] = (u32x4){0u, 0u, 0u, 0u}; \
        if (idx < NCH) { const int row = idx / 72, ch = idx - row * 72, key = (t) * 32 + row; if (key < TK_S) st[i] = ch < 64 ? *(const u32x4*)(SKL + (size_t)key * 512 + ch * 8) : *(const u32x4*)(SKP + (size_t)key * 64 + (ch - 64) * 8); } } } while (0)
#define SA_WRITE(buf) do { _Pragma("unroll") for (int i = 0; i < 5; ++i) { const int idx = tid + i * 512; if (idx < NCH) { const int row = idx / 72, ch = idx - row * 72; *(LAS u32x4*)(lds + (buf) * SA_BUF + row * SA_P + ch * 16) = st[i]; } } } while (0)
    f32x4 o[16]; for (int d = 0; d < 16; ++d) o[d] = (f32x4){0.f, 0.f, 0.f, 0.f};
    float m_run = -1e30f, l_run = 0.f;
    const int trb = (4 * g + (l15 >> 2)) * SA_P + (dvh * 256 + 4 * (l15 & 3)) * 2;
    SA_LOAD(0); SA_WRITE(0); __syncthreads();
    for (int t = 0; t < NT; ++t) {
        const int buf = t & 1;
        if (t + 1 < NT) SA_LOAD(t + 1);
        LAS const unsigned char* bb = lds + buf * SA_BUF;
        f32x4 p[2];
#pragma unroll
        for (int blk = 0; blk < 2; ++blk) { p[blk] = (f32x4){0.f, 0.f, 0.f, 0.f};
#pragma unroll
            for (int ks = 0; ks < 18; ++ks) { const bf16x8 a = *(LAS const bf16x8*)(bb + (16 * blk + l15) * SA_P + (ks * 32 + 8 * g) * 2); p[blk] = MFMA16(a, qf[ks], p[blk]); } }
        if (t == NT - 1) {
#pragma unroll
            for (int blk = 0; blk < 2; ++blk)
#pragma unroll
                for (int r = 0; r < 4; ++r) if (t * 32 + 16 * blk + 4 * g + r >= TK_S) p[blk][r] = -INFINITY; }
        float mx = fmaxf(fmaxf(fmaxf(p[0][0], p[0][1]), fmaxf(p[0][2], p[0][3])), fmaxf(fmaxf(p[1][0], p[1][1]), fmaxf(p[1][2], p[1][3])));
        mx = fmaxf(mx, __shfl_xor(mx, 16)); mx = fmaxf(mx, __shfl_xor(mx, 32));
        const float m_new = fmaxf(m_run, mx), alpha = __builtin_amdgcn_exp2f(m_run - m_new); m_run = m_new;
        float ps = 0.f;
#pragma unroll
        for (int blk = 0; blk < 2; ++blk)
#pragma unroll
            for (int r = 0; r < 4; ++r) { p[blk][r] = __builtin_amdgcn_exp2f(p[blk][r] - m_new); ps += p[blk][r]; }
        l_run = l_run * alpha + ps;
        u32x4 pw; pw.x = pk2(p[0][0], p[0][1]); pw.y = pk2(p[0][2], p[0][3]); pw.z = pk2(p[1][0], p[1][1]); pw.w = pk2(p[1][2], p[1][3]);
        const bf16x8 pf = __builtin_bit_cast(bf16x8, pw);
#pragma unroll
        for (int d = 0; d < 16; ++d) { o[d] *= alpha; const s16x4 lo = lds_tr(bb + trb + d * 32), hh = lds_tr(bb + trb + 16 * SA_P + d * 32); o[d] = MFMA16(cat8(lo, hh), pf, o[d]); }
        __syncthreads();
        if (t + 1 < NT) { SA_WRITE(buf ^ 1); }
        __syncthreads();
    }
    float lt = l_run; lt += __shfl_xor(lt, 16); lt += __shfl_xor(lt, 32);
    const float inv = 1.f / lt;
    const bf16_t* wuv = WSP(bf16_t, WS_WUVT) + (size_t)(head * 128 + l15) * 512 + dvh * 256 + 4 * g;
    f32x4 oe[8]; for (int e = 0; e < 8; ++e) oe[e] = (f32x4){0.f, 0.f, 0.f, 0.f};
#pragma unroll
    for (int i = 0; i < 8; ++i) { u32x4 bw; bw.x = pk2(o[2 * i][0] * inv, o[2 * i][1] * inv); bw.y = pk2(o[2 * i][2] * inv, o[2 * i][3] * inv); bw.z = pk2(o[2 * i + 1][0] * inv, o[2 * i + 1][1] * inv); bw.w = pk2(o[2 * i + 1][2] * inv, o[2 * i + 1][3] * inv);
        const bf16x8 bf = __builtin_bit_cast(bf16x8, bw);
#pragma unroll
        for (int e = 0; e < 8; ++e) { const bf16_t* wp = wuv + (size_t)e * 16 * 512 + 32 * i; const u32x2 a0 = *(const u32x2*)wp, a1 = *(const u32x2*)(wp + 16);
            const u32x4 aw = {a0.x, a0.y, a1.x, a1.y}; oe[e] = MFMA16(__builtin_bit_cast(bf16x8, aw), bf, oe[e]); } }
    LAS float* red = (LAS float*)lds + (wid & 3) * 2048;
    if (dvh == 1) {
#pragma unroll
        for (int e = 0; e < 8; ++e) *(LAS f32x4*)(red + (e * 64 + lane) * 4) = oe[e]; }
    __syncthreads();
    if (dvh == 0) { bf16_t* orow = Q + (size_t)(R_SAMPLE + b * 16 + l15) * QP + head * 128 + 4 * g;
#pragma unroll
        for (int e = 0; e < 8; ++e) { const f32x4 v = oe[e] + *(LAS const f32x4*)(red + (e * 64 + lane) * 4); u32x2 w; w.x = pk2(v[0], v[1]); w.y = pk2(v[2], v[3]); *(u32x2*)(orow + 16 * e) = w; } }
    __syncthreads();
#undef SA_LOAD
#undef SA_WRITE
}
constexpr int GL_QP = 528, GL_KP = 144, GL_VP = 272, GL_AP = 144;
constexpr int GL_QD = 0, GL_KI = 64 * GL_QP, GL_KET = 2 * 64 * GL_QP, GL_V = GL_KET + 256 * GL_KP, GL_ATT = GL_V + 64 * GL_VP, GL_DEC = GL_ATT + 64 * GL_AP, GL_END = GL_DEC + 1024;
static_assert(GL_END <= RING_BYTES + 4096, "GLA LDS");
template <bool SAMPLE>
__device__ __forceinline__ void gla_unit(const Ptrs& P, LAS unsigned char* lds, const int wid, int h, int dvb, int b  ) {
    const int lane = lane_now(), tid = wid * 64 + lane, l15 = lane & 15, g = lane >> 4;
    bf16_t* H = WSP(bf16_t, WS_H); const bf16_t* KET = WSP(bf16_t, WS_KET);
    const int dvcol = h * 512 + dvb * 128;
    f32x4 S[16];
    if (SAMPLE) { const char* s0 = (const char*)(P.state_gla + ((size_t)(b * 4 + h) * 256) * 512 + dvb * 128 + 16 * wid); const unsigned vo = (unsigned)((4 * g) * 512 + l15) * 4u;
#pragma unroll
        for (int i = 0; i < 16; ++i) {
#pragma unroll
            for (int r = 0; r < 4; ++r) S[i][r] = *(const float*)(s0 + (vo + (unsigned)((16 * i + r) * 2048)));
            asm volatile("" ::: "memory"); } }
    else {
#pragma unroll
        for (int i = 0; i < 16; ++i) S[i] = (f32x4){0.f, 0.f, 0.f, 0.f}; }
    const int nch = SAMPLE ? 1 : 129;
    u32x4 sQ[4], sK[4], sE[4], sV[2]; float sD = 0.f;
#define GL_LOAD_B(ci) do { const int jb = SAMPLE ? 128 + (b >> 2) : ((ci) == 0 ? 136 : (ci) - 1); const int row0 = SAMPLE ? R_SAMPLE + 16 * b : 64 * jb; \
        _Pragma("unroll") for (int i = 0; i < 4; ++i) { const int idx = tid + i * 512, r = idx >> 5, c = idx & 31; const bool ok = !SAMPLE || r < 16; const bf16_t* hp = H + (size_t)(row0 + r) * NH + h * 256 + c * 8; \
            sQ[i] = ok ? *(const u32x4*)(hp + HC_Q) : (u32x4){0u, 0u, 0u, 0u}; sK[i] = ok ? *(const u32x4*)(hp + HC_K) : (u32x4){0u, 0u, 0u, 0u}; } } while (0)
#define GL_LOAD_A(ci) do { const int jb = SAMPLE ? 128 + (b >> 2) : ((ci) == 0 ? 136 : (ci) - 1); const int row0 = SAMPLE ? R_SAMPLE + 16 * b : 64 * jb; \
        _Pragma("unroll") for (int i = 0; i < 4; ++i) { const int idx = tid + i * 512, dk = idx >> 3, c = idx & 7; \
            if (!SAMPLE) sE[i] = *(const u32x4*)(KET + ((size_t)(jb * 4 + h) * 256 + dk) * 64 + c * 8); \
            else sE[i] = c < 2 ? *(const u32x4*)(KET + ((size_t)(jb * 4 + h) * 256 + dk) * 64 + 16 * (b & 3) + c * 8) : (u32x4){0u, 0u, 0u, 0u}; } \
        _Pragma("unroll") for (int i = 0; i < 2; ++i) { const int idx = tid + i * 512, r = idx >> 4, c = idx & 15; const bool ok = !SAMPLE || r < 16; \
            sV[i] = ok ? *(const u32x4*)(H + (size_t)(row0 + r) * NH + HC_V + dvcol + c * 8) : (u32x4){0u, 0u, 0u, 0u}; } \
        if (tid < 256) sD = SAMPLE ? WSP(float, WS_DECS)[b * 1024 + h * 256 + tid] : WSP(float, WS_DECP)[jb * 1024 + h * 256 + tid]; } while (0)
#define GL_WRITE() do { \
        _Pragma("unroll") for (int i = 0; i < 4; ++i) { const int idx = tid + i * 512, r = idx >> 5, c = idx & 31; *(LAS u32x4*)(lds + GL_QD + r * GL_QP + c * 16) = sQ[i]; *(LAS u32x4*)(lds + GL_KI + r * GL_QP + c * 16) = sK[i]; } \
        _Pragma("unroll") for (int i = 0; i < 4; ++i) { const int idx = tid + i * 512, dk = idx >> 3, c = idx & 7; *(LAS u32x4*)(lds + GL_KET + dk * GL_KP + c * 16) = sE[i]; } \
        _Pragma("unroll") for (int i = 0; i < 2; ++i) { const int idx = tid + i * 512, r = idx >> 4, c = idx & 15; *(LAS u32x4*)(lds + GL_V + r * GL_VP + c * 16) = sV[i]; } \
        if (tid < 256) *(LAS float*)(lds + GL_DEC + tid * 4) = sD; } while (0)
    for (int ci = 0; ci < nch; ++ci) {
        GL_LOAD_A(ci); GL_LOAD_B(ci); GL_WRITE();
        __syncthreads();
        const int jb = SAMPLE ? 128 + (b >> 2) : (ci == 0 ? 136 : ci - 1); const int row0 = SAMPLE ? R_SAMPLE + 16 * b : 64 * jb;
#pragma unroll
        for (int k2 = 0; k2 < 2; ++k2) { const int tt = 2 * wid + k2, st = tt >> 2, ct = tt & 3; f32x4 a = (f32x4){0.f, 0.f, 0.f, 0.f};
            if (st <= ct) {
#pragma unroll
                for (int ks = 0; ks < 8; ++ks) { const bf16x8 af = *(LAS const bf16x8*)(lds + GL_KI + (16 * st + l15) * GL_QP + (ks * 32 + 8 * g) * 2), bf = *(LAS const bf16x8*)(lds + GL_QD + (16 * ct + l15) * GL_QP + (ks * 32 + 8 * g) * 2);
                    a = MFMA16(af, bf, a); }
                if (st == ct) {
#pragma unroll
                    for (int r = 0; r < 4; ++r) if (4 * g + r > l15) a[r] = 0.f; } }
            u32x2 w; w.x = pk2(a[0], a[1]); w.y = pk2(a[2], a[3]); *(LAS u32x2*)(lds + GL_ATT + (16 * ct + l15) * GL_AP + (16 * st + 4 * g) * 2) = w; }
        bf16x8 vf[2];
#pragma unroll
        for (int k2 = 0; k2 < 2; ++k2) { LAS const unsigned char* vp = lds + GL_V + (32 * k2 + 8 * g + (l15 >> 2)) * GL_VP + (16 * wid + 4 * (l15 & 3)) * 2; vf[k2] = cat8(lds_tr(vp), lds_tr(vp + 4 * GL_VP)); }
        __syncthreads();
        f32x4 o[4];
#pragma unroll
        for (int ct = 0; ct < 4; ++ct) o[ct] = (f32x4){0.f, 0.f, 0.f, 0.f};
#pragma unroll
        for (int ks = 0; ks < 8; ++ks) { u32x4 sw; sw.x = pk2(S[2 * ks][0], S[2 * ks][1]); sw.y = pk2(S[2 * ks][2], S[2 * ks][3]); sw.z = pk2(S[2 * ks + 1][0], S[2 * ks + 1][1]); sw.w = pk2(S[2 * ks + 1][2], S[2 * ks + 1][3]);
            const bf16x8 sf = __builtin_bit_cast(bf16x8, sw);
#pragma unroll
            for (int ct = 0; ct < 4; ++ct) { if (SAMPLE && ct > 0) continue; LAS const unsigned char* qp = lds + GL_QD + (16 * ct + l15) * GL_QP + (32 * ks + 4 * g) * 2; const u32x2 q0 = *(LAS const u32x2*)qp, q1 = *(LAS const u32x2*)(qp + 32);
                const u32x4 qw = {q0.x, q0.y, q1.x, q1.y}; o[ct] = MFMA16(sf, __builtin_bit_cast(bf16x8, qw), o[ct]); } }
#pragma unroll
        for (int k2 = 0; k2 < 2; ++k2)
#pragma unroll
            for (int ct = 0; ct < 4; ++ct) { if (SAMPLE && (ct > 0 || k2 > 0)) continue; if (32 * k2 > 16 * ct + 15) continue;
                const bf16x8 bf = *(LAS const bf16x8*)(lds + GL_ATT + (16 * ct + l15) * GL_AP + (32 * k2 + 8 * g) * 2); o[ct] = MFMA16(vf[k2], bf, o[ct]); }
#pragma unroll
        for (int ct = 0; ct < 4; ++ct) { if (SAMPLE && ct > 0) continue; u32x2 w; w.x = pk2(o[ct][0], o[ct][1]); w.y = pk2(o[ct][2], o[ct][3]);
            *(u32x2*)(H + (size_t)(row0 + 16 * ct + l15) * NH + HC_V + dvcol + 16 * wid + 4 * g) = w; }
#pragma unroll
        for (int i = 0; i < 16; ++i) { const f32x4 d4 = *(LAS const f32x4*)(lds + GL_DEC + (16 * i + 4 * g) * 4); S[i] *= d4;
#pragma unroll
            for (int k2 = 0; k2 < 2; ++k2) { if (SAMPLE && k2 > 0) continue; const bf16x8 af = *(LAS const bf16x8*)(lds + GL_KET + (16 * i + l15) * GL_KP + (32 * k2 + 8 * g) * 2); S[i] = MFMA16(af, vf[k2], S[i]); } }
        __syncthreads();
    }
    { char* so = (char*)(P.out + (SAMPLE ? O_GSS + (size_t)(b * 4 + h) * 256 * 512 : O_GSP + (size_t)h * 256 * 512) + dvb * 128 + 16 * wid);
      const int ln = lane_now(); const unsigned vo = (unsigned)((4 * (ln >> 4)) * 512 + (ln & 15)) * 4u;
#pragma unroll
      for (int i = 0; i < 16; ++i) {
#pragma unroll
        for (int r = 0; r < 4; ++r) *(float*)(so + (vo + (unsigned)((16 * i + r) * 2048))) = S[i][r];
        asm volatile("" ::: "memory"); } }
#undef GL_LOAD_A
#undef GL_LOAD_B
#undef GL_WRITE
}
#ifndef MK_N_LAUNCHES
#define MK_N_LAUNCHES 1
#endif
constexpr int N_PHASES = 10;
struct Args { const float* in[24]; float* out; unsigned char* ws; int ph_lo, ph_hi; };

__global__ void __launch_bounds__(512, 2) fwd_megakernel(Args args) {
    extern __shared__ __attribute__((aligned(16))) unsigned char lds_raw[];
    LAS unsigned char* lds = (LAS unsigned char*)lds_raw;
    volatile LAS unsigned* MISC = (volatile LAS unsigned*)(lds + MISC_OFF);
    Ptrs P;
    P.x_prompt = args.in[0]; P.x_sample = args.in[1]; P.cache_lat = args.in[2]; P.cache_krope = args.in[3]; P.state_gla = args.in[4]; P.cache_conv = args.in[5]; P.meta = args.in[6]; P.g_mix = args.in[7];
    P.w_in = args.in[8]; P.w_a2 = args.in[9]; P.b_a = args.in[10]; P.g_gla = args.in[11]; P.g_q = args.in[12]; P.w_uq = args.in[13]; P.g_kv = args.in[14]; P.w_uk = args.in[15]; P.w_uv = args.in[16]; P.w_o = args.in[17];
    P.g_ffn = args.in[18]; P.w_up = args.in[19]; P.conv_w = args.in[20]; P.conv_b = args.in[21]; P.w_down = args.in[22]; P.final_norm = args.in[23]; P.out = args.out; P.ws = args.ws;
    WaveCtx C; C.lds = lds; C.wave = __builtin_amdgcn_readfirstlane(threadIdx.x >> 6);
    const int G = gridDim.x, bx = blockIdx.x;
    C.gw = bx * 8 + C.wave; C.ngw = G * 8;
    if (threadIdx.x < 32) MISC[threadIdx.x] = 0u;
    const bool tid0 = (threadIdx.x == 0);
    __syncthreads();
    unsigned* ctl = (unsigned*)(P.ws + WS_CTL);
    const int lo = args.ph_lo, hi = args.ph_hi;
    XcdBarrier bar; bar.bar = ctl + CW_BAR; bar.x = 0; bar.st = nullptr;
    if (hi - lo > 1) bar = xcd_barrier_post(ctl + CW_BAR, MISC + 8, tid0);
#ifndef PH_MASK
#define PH_MASK 0x3ff
#endif
#define IN(k) (((PH_MASK >> (k)) & 1) && lo <= (k) && (k) < hi)
#define SEAM(k) do { if (IN(k) && IN((k) + 1)) xcd_barrier(bar, C.wave); } while (0)

    if (IN(0)) { p0_prologue(P, C); }
    SEAM(0);
    if (IN(1)) {
        { SchedPlain S; S.o.init(NMT, NH / 256, G, bx); S.A = (const char*)WSP(bf16_t, WS_XBF); S.Bt = (const char*)WSP(bf16_t, WS_W1T); S.a_tile = (size_t)256 * DM * 2; S.b_tile = (size_t)256 * DM * 2;
          EpiInProj E{WSP(bf16_t, WS_H), WSP(float, WS_RSX), WSP(float, WS_SS)};
          pg8::gemm_phase(lds, C.wave, DM, DM, DM, S, E); }
        p1_wabs(P, C);
    }
    SEAM(1);
    if (IN(2)) {
        p2_rows(P, C);
        __syncthreads();
        SchedP2 S{G, bx, (const char*)P.ws};
        EpiP2 E{WSP(bf16_t, WS_Q), WSP(bf16_t, WS_KV), WSP(bf16_t, WS_QLAT), WSP(bf16_t, WS_WABS), WSP(float, WS_SS), WSP(f32x2, WS_ROPE)};
        pg8::gemm_phase(lds, C.wave, NH, 512, 512, S, E);
    }
    SEAM(2);
    if (IN(3)) {
        for (;;) {
            if (C.wave == 0 && lane_now() == 0) MISC[0] = __hip_atomic_fetch_add(ctl + CW_QUEUE, 1u, RLX_AGENT);
            __syncthreads();
            const int idx = (int)MISC[0];
            __syncthreads();
            if (idx >= 1184) break;
#ifndef UNIT_MASK
#define UNIT_MASK 15
#endif
            if (idx < 16) { if (UNIT_MASK & 1) gla_unit<false>(P, lds, C.wave, idx >> 2, idx & 3, 0); }
            else if (idx < 560 && (idx < 432 ? false : true)) { const int s = idx - 432; if (UNIT_MASK & 4) attn_sample_unit(P, lds, C.wave, s >> 2, s & 3); }
            else if (idx < 672) { int h, qrow0, npr, tl;
                if (idx < 32) { h = idx - 16; qrow0 = R_META; npr = 0; tl = 0; }
                else { const int a = idx < 432 ? idx - 32 : idx - 560 + 400, qb = 31 - (a >> 4); h = a & 15; qrow0 = 256 * qb; npr = 4 * qb + 4; tl = 4 * qb; }
                if (UNIT_MASK & 2) attn_prompt_unit(P, lds, C.wave, h, qrow0, npr, tl); }
            else { const int gs = idx - 672; if (UNIT_MASK & 8) gla_unit<true>(P, lds, C.wave, (gs >> 2) & 3, gs & 3, gs >> 4); }
        }
    }
    SEAM(3);
    if (IN(4)) { p4_merge(P, C); }
    SEAM(4);
    if (IN(5)) {
        SchedPlain S; S.o.init(NMT, DM / 256, G, bx); S.A = (const char*)WSP(bf16_t, WS_MERGED); S.Bt = (const char*)WSP(bf16_t, WS_WOT); S.a_tile = (size_t)256 * DM * 2; S.b_tile = (size_t)256 * DM * 2;
        EpiOut E{P.x_prompt, P.x_sample, P.meta, P.out, WSP(float, WS_X2M), WSP(bf16_t, WS_X2B), WSP(float, WS_SS2)};
        pg8::gemm_phase(lds, C.wave, DM, DM, DM, S, E);
    }
    SEAM(5);
    if (IN(6)) {
        SchedPlain S; S.o.init(NMT, DFF2 / 256, G, bx); S.A = (const char*)WSP(bf16_t, WS_X2B); S.Bt = (const char*)WSP(bf16_t, WS_WUPT); S.a_tile = (size_t)256 * DM * 2; S.b_tile = (size_t)256 * DM * 2;
        EpiUp E{WSP(bf16_t, WS_H)};
        pg8::gemm_phase(lds, C.wave, DM, DM, DM, S, E);
    }
    SEAM(6);
    if (IN(7)) { p7_conv(P, C); }
    SEAM(7);
    if (IN(8)) {
        SchedPlain S; S.o.init(34, DM / 256, G, bx); S.A = (const char*)WSP(bf16_t, WS_GATE); S.Bt = (const char*)WSP(bf16_t, WS_WDT); S.a_tile = (size_t)256 * DFF * 2; S.b_tile = (size_t)256 * DFF * 2;
        EpiDown E{P.out};
        pg8::gemm_phase(lds, C.wave, DFF, DFF, DFF, S, E);
    }
    SEAM(8);
    if (IN(9)) { p9_final(P, C); }
#undef IN
#undef SEAM
}

extern "C" void kernel_launch(void* const* d_in, const int* in_sizes, int n_in, void* d_out, int out_size, void* d_ws, size_t ws_size, hipStream_t stream) {
    static int grid = 0;
    if (grid == 0) {
        if (n_in != 24 || out_size != (int)O_END || ws_size < WS_END) { fprintf(stderr, "kernel_launch: shape mismatch: n_in %d out %d ws %zu (need 24, %zu, >= %zu); nothing launched\n", n_in, out_size, ws_size, (size_t)O_END, (size_t)WS_END); grid = -1; return; }
        int dev = 0, cus = 0, per_cu = 0;
        if (hipGetDevice(&dev) != hipSuccess || hipDeviceGetAttribute(&cus, hipDeviceAttributeMultiprocessorCount, dev) != hipSuccess) { fprintf(stderr, "kernel_launch: device query failed\n"); grid = -1; return; }
        if (hipFuncSetAttribute((const void*)fwd_megakernel, hipFuncAttributeMaxDynamicSharedMemorySize, LDS_BYTES) != hipSuccess) { fprintf(stderr, "kernel_launch: hipFuncSetAttribute failed\n"); grid = -1; return; }
        if (hipOccupancyMaxActiveBlocksPerMultiprocessor(&per_cu, (const void*)fwd_megakernel, 512, LDS_BYTES) != hipSuccess || per_cu < 1) { fprintf(stderr, "kernel_launch: occupancy query reports %d blocks per CU\n", per_cu); per_cu = 1; }
        (void)hipGetLastError();
        grid = cus;
        fprintf(stderr, "kernel_launch: grid %d (cus %d, occupancy %d/CU), ws %zu\n", grid, cus, per_cu, ws_size);
    }
    if (grid < 0) return;
    if (hipMemsetAsync((char*)d_ws + WS_CTL, 0, CTL_ZERO_BYTES, stream) != hipSuccess) { fprintf(stderr, "kernel_launch: memset failed\n"); return; }
    Args a{};
    for (int i = 0; i < 24; ++i) a.in[i] = (const float*)d_in[i];
    a.out = (float*)d_out; a.ws = (unsigned char*)d_ws;
    if (MK_N_LAUNCHES == 1) { a.ph_lo = 0; a.ph_hi = N_PHASES; hipLaunchKernelGGL(fwd_megakernel, dim3(grid), dim3(512), LDS_BYTES, stream, a); }
    else { for (int p = 0; p < N_PHASES; ++p) { a.ph_lo = p; a.ph_hi = p + 1; hipLaunchKernelGGL(fwd_megakernel, dim3(grid), dim3(512), LDS_BYTES, stream, a); } }
    const hipError_t le = hipPeekAtLastError();
    if (le != hipSuccess) fprintf(stderr, "kernel_launch: launch failed: %s\n", hipGetErrorName(le));
}
```

```cpp
#include <hip/hip_runtime.h>
#include <cstdio>
#include <cstdint>

#define LAS __attribute__((address_space(3)))
#define GAS __attribute__((address_space(1)))
typedef unsigned short bf16_t;
typedef short bf16x8 __attribute__((ext_vector_type(8)));
typedef short s16x4 __attribute__((ext_vector_type(4)));
typedef float f32x2 __attribute__((ext_vector_type(2)));
typedef float f32x4 __attribute__((ext_vector_type(4)));
typedef float f32x16 __attribute__((ext_vector_type(16)));
typedef unsigned u32x2 __attribute__((ext_vector_type(2)));
typedef unsigned u32x4 __attribute__((ext_vector_type(4)));
typedef __bf16 bf16x2_t __attribute__((ext_vector_type(2)));
typedef GAS unsigned gu32;

#define MFMA32(a, b, c) __builtin_amdgcn_mfma_f32_32x32x16_bf16((a), (b), (c), 0, 0, 0)
#define MFMA16(a, b, c) __builtin_amdgcn_mfma_f32_16x16x32_bf16((a), (b), (c), 0, 0, 0)
#define RLX_AGENT __ATOMIC_RELAXED, __HIP_MEMORY_SCOPE_AGENT

__device__ __forceinline__ unsigned pk2(float lo, float hi) { f32x2 v = {lo, hi}; bf16x2_t b = __builtin_convertvector(v, bf16x2_t); return __builtin_bit_cast(unsigned, b); }
__device__ __forceinline__ float bflo(unsigned u) { return __uint_as_float(u << 16); }
__device__ __forceinline__ float bfhi(unsigned u) { return __uint_as_float(u & 0xffff0000u); }
__device__ __forceinline__ float bf1(bf16_t u) { return __uint_as_float(((unsigned)u) << 16); }
__device__ __forceinline__ bf16_t f2bf(float f) { return (bf16_t)(pk2(f, 0.f) & 0xffffu); }
__device__ __forceinline__ int lane_now() { int l; asm volatile("v_mbcnt_lo_u32_b32 %0, -1, 0\n\tv_mbcnt_hi_u32_b32 %0, -1, %0" : "=v"(l)); return l; }
__device__ __forceinline__ float wave_sum(float v) {
#pragma unroll
    for (int o = 1; o < 64; o <<= 1) v += __shfl_xor(v, o);
    return v;
}
__device__ __forceinline__ float sigmoidf_(float x) { return 1.f / (1.f + __expf(-x)); }
__device__ __forceinline__ s16x4 lds_tr(LAS const unsigned char* p) { typedef short v4i16_t __attribute__((ext_vector_type(4))); return __builtin_bit_cast(s16x4, __builtin_amdgcn_ds_read_tr16_b64_v4i16((LAS v4i16_t*)p)); }
__device__ __forceinline__ bf16x8 cat8(s16x4 lo, s16x4 hi) { return (bf16x8){lo[0], lo[1], lo[2], lo[3], hi[0], hi[1], hi[2], hi[3]}; }

constexpr int DM = 2048, T_P = 8192, N_META = 16, DEC_B = 32, DEC_T = 16, PAST = 1024, TK_S = PAST + DEC_T;
constexpr int R_SAMPLE = 8192, R_META = 8704, M_REAL = 8720, M_PAD = 8960, NMT = 35;
constexpr int NH = 11520;
constexpr int HC_Q = 0, HC_K = 1024, HC_V = 2048, HC_R = 4096, HC_CQ = 6144, HC_CKV = 6656, HC_GA = 7168, HC_GB = 9216, HC_KPE = 11264, HC_AG = 11328;
constexpr int IN_COLS = 11344;
constexpr int QP = 3072;
constexpr int DFF = 5632, DFF2 = 11264;
constexpr float EPS = 1e-6f;
constexpr float QSCALE = 0.07216878364870322f * 1.4426950408889634f;

constexpr size_t O_YP = 0, O_YS = 16777216, O_LATP = 17825792, O_KRP = 22028288, O_GSP = 22553600, O_CVP = 23077888, O_LATS = 23100416, O_KRS = 23362560, O_GSS = 23395328, O_CVS = 40172544, O_END = 40893440;

constexpr size_t MiB = 1u << 20;
constexpr size_t WS_CTL = 0, CTL_ZERO_BYTES = 256 * 1024;
constexpr size_t WS_RSX = 1 * MiB;
constexpr size_t WS_SS = 1 * MiB + 256 * 1024;
constexpr size_t WS_SS2 = 2 * MiB;
constexpr size_t WS_ROPE = 3 * MiB + 512 * 1024;
constexpr size_t WS_DECP = 6 * MiB;
constexpr size_t WS_DECS = 6 * MiB + 640 * 1024;
constexpr size_t WS_KPE = 6 * MiB + 768 * 1024;
constexpr size_t WS_WOT = 8 * MiB, WS_WUVT = 16 * MiB, WS_WQT = 18 * MiB, WS_WKVT = 21 * MiB, WS_WUKN = 25 * MiB, WS_WUQN = 27 * MiB, WS_WABS = 30 * MiB, WS_X2M = 38 * MiB;
constexpr size_t WS_H = 40 * MiB;
constexpr size_t WS_R3 = 238 * MiB;
constexpr size_t WS_XBF = WS_R3;
constexpr size_t WS_Q = WS_R3, WS_SKL = WS_R3 + 53 * MiB, WS_SKP = WS_R3 + 86 * MiB, WS_QLAT = WS_R3 + 91 * MiB;
constexpr size_t WS_X2B = WS_R3, WS_WUPT = WS_R3 + 53 * MiB;
constexpr size_t WS_GATE = WS_R3;
constexpr size_t WS_R4 = 338 * MiB;
constexpr size_t WS_W1T = WS_R4;
constexpr size_t WS_KV = WS_R4, WS_KET = WS_R4 + 66 * MiB;
constexpr size_t WS_MERGED = WS_R4, WS_WDT = WS_R4 + 35 * MiB;
constexpr size_t WS_OG = 422 * MiB;
constexpr size_t WS_END = 457 * MiB;
static_assert(WS_W1T + (size_t)NH * DM * 2 <= WS_OG && WS_XBF + (size_t)M_PAD * DM * 2 <= WS_SKL && WS_QLAT + (size_t)512 * 8192 * 2 <= WS_R4 && WS_SKL + (size_t)DEC_B * TK_S * 512 * 2 <= WS_SKP && WS_SKP + (size_t)DEC_B * TK_S * 64 * 2 <= WS_QLAT, "R3 map");
static_assert(WS_Q + (size_t)M_PAD * QP * 2 <= WS_SKL && WS_WUPT + (size_t)DFF2 * DM * 2 <= WS_R4 && WS_GATE + (size_t)M_PAD * DFF * 2 <= WS_R4, "R3 map 2");
static_assert(WS_KV + (size_t)33 * 256 * 4096 * 2 <= WS_KET && WS_KET + (size_t)140 * 4 * 256 * 64 * 2 <= WS_OG && WS_WDT + (size_t)DM * DFF * 2 <= WS_OG && WS_OG + (size_t)M_PAD * DM * 2 <= WS_END && WS_MERGED + (size_t)M_PAD * DM * 2 <= WS_WDT, "R4 map");
static_assert(WS_H + (size_t)M_PAD * NH * 2 <= WS_R3 && WS_WABS + (size_t)8192 * 512 * 2 <= WS_X2M && WS_X2M + 2 * MiB <= WS_H, "H map");
constexpr int CW_BAR = 1024;
constexpr int CW_QUEUE = 8192;
constexpr int CW_QUEUE2 = 8256;
constexpr int CW_QUEUE6S = 8512;
constexpr int CW_QUEUE6 = 8448;
constexpr int CW_QUEUE1 = 8320;
constexpr int CW_QUEUE4 = 8384;
constexpr int CW_SKF5 = 9216, CW_SKF8 = 10240;

constexpr int RING_BYTES = 131072, MISC_OFF = 163584, LDS_BYTES = 163840;
#define XB_TMO      128
#define XB_XCNT(j)  (256  + 64 * (j))
#define XB_XSUB(j)  (1280 + 64 * (j))
#define XB_XGEN(j)  (2304 + 64 * (j))
#define XB_TOP      3328
#define XB_TOPGEN   3392
#define XCD_BAR_WORDS 3456
#define XB_SPIN_CAP (1u << 18)
__device__ __forceinline__ unsigned xb_ld(unsigned* p)              { return __hip_atomic_load(p, __ATOMIC_RELAXED, __HIP_MEMORY_SCOPE_AGENT); }
__device__ __forceinline__ unsigned xb_add(unsigned* p, unsigned v) { return __hip_atomic_fetch_add(p, v, __ATOMIC_RELAXED, __HIP_MEMORY_SCOPE_AGENT); }
__device__ __forceinline__ unsigned xb_xcc_id() { return (unsigned)__builtin_amdgcn_s_getreg((3 << 11) | 20) & 0xFu; }
#define XB_SPIN(cond, bar) do { unsigned _sp = 0; while (cond) { __builtin_amdgcn_s_sleep(1); \
    if ((++_sp & 255u) == 0u) { if (xb_ld(&(bar)[XB_TMO])) break; if (_sp > XB_SPIN_CAP) { atomicAdd(&(bar)[XB_TMO], 1u); break; } } } } while (0)
struct XcdBarrier { unsigned* bar; unsigned x; volatile LAS unsigned* st; };
__device__ __forceinline__ XcdBarrier xcd_barrier_post(unsigned* bar, volatile LAS unsigned* st, bool tid0) {
    XcdBarrier b; b.bar = bar; b.x = xb_xcc_id(); b.st = st;
    if (tid0) (void)xb_add(&bar[XB_XCNT(b.x)], 1u);
    return b;
}
__device__ __forceinline__ void xcd_barrier_complete(unsigned* bar, unsigned x, unsigned& nloc, unsigned& nx) {
    const unsigned G = gridDim.x * gridDim.y * gridDim.z;
    unsigned sum, cnt, mine, sp = 0u;
    for (;;) {
        sum = 0u; cnt = 0u; mine = 0u;
#pragma unroll
        for (unsigned j = 0; j < 16; ++j) { const unsigned c = xb_ld(&bar[XB_XCNT(j)]); sum += c; cnt += (c > 0u) ? 1u : 0u; mine = (j == x) ? c : mine; }
        if (sum == G) break;
        __builtin_amdgcn_s_sleep(1);
        if ((++sp & 255u) == 0u) { if (xb_ld(&bar[XB_TMO])) break; if (sp > XB_SPIN_CAP) { atomicAdd(&bar[XB_TMO], 1u); break; } }
    }
    nloc = mine > 0u ? mine : 1u; nx = cnt > 0u ? cnt : 1u;
}
__device__ __forceinline__ void xcd_barrier(const XcdBarrier& b, int wave) {
    asm volatile("s_waitcnt vmcnt(0)" ::: "memory");
    __syncthreads();
    if (wave == 0 && lane_now() == 0) {
        unsigned* bar = b.bar;
        __builtin_amdgcn_s_waitcnt(0);
        unsigned nloc = b.st[0], nx = b.st[1];
        if (nloc == 0u) { xcd_barrier_complete(bar, b.x, nloc, nx); b.st[0] = nloc; b.st[1] = nx; }
        const unsigned old = xb_add(&bar[XB_XSUB(b.x)], 1u);
        const unsigned gen = old / nloc;
        if (old + 1u == (gen + 1u) * nloc) {
            __builtin_amdgcn_fence(__ATOMIC_RELEASE, "agent");
            asm volatile("s_waitcnt vmcnt(0)" ::: "memory");
            const unsigned og = xb_add(&bar[XB_TOP], 1u);
            const unsigned tg = og / nx;
            if (og + 1u == (tg + 1u) * nx) xb_add(&bar[XB_TOPGEN], 1u);
            else XB_SPIN(xb_ld(&bar[XB_TOPGEN]) == tg, bar);
            __builtin_amdgcn_fence(__ATOMIC_ACQUIRE, "agent");
            xb_add(&bar[XB_XGEN(b.x)], 1u);
            asm volatile("s_waitcnt vmcnt(0)" ::: "memory");
        } else {
            XB_SPIN(xb_ld(&bar[XB_XGEN(b.x)]) == gen, bar);
            __builtin_amdgcn_fence(__ATOMIC_ACQUIRE, "agent");
            asm volatile("s_waitcnt vmcnt(0)" ::: "memory");
        }
    }
    __syncthreads();
}

namespace pg8 {
constexpr int BM = 256, BK = 64, HALF = 128, HTB = HALF * BK * 2, STAGE_BYTES = 8 * HTB;
__host__ __device__ __forceinline__ int lds_byte(int r, int c) { const int st = (r >> 4) * 2 + (c >> 5), rr = r & 15, cc = c & 31, ob = rr * 64 + cc * 2; return st * 1024 + (ob ^ (((ob >> 9) & 1) << 5)); }
__host__ __device__ __forceinline__ void stage_rc(int b, int& R, int& C) { const int st = b / 1024, sb = b % 1024, swz = sb ^ (((sb >> 9) & 1) << 5); R = (st >> 1) * 16 + swz / 64; C = (st & 1) * 32 + (swz % 64) / 2; }
__host__ __device__ __forceinline__ int perm32(int rho) { const int n = rho >> 4, i = rho & 15; return 8 * (i >> 2) + 4 * n + (i & 3); }
struct Unit { int pm, pn, kind, nt, part, half, nhalf; };
typedef f32x4 Acc[2][2][4][2];

struct SkRange { int hp, p0, p1; };
__device__ __forceinline__ SkRange sk_range(int ntiles, int hp, int G, int v) { const long tot = (long)ntiles * hp; SkRange r; r.hp = hp; r.p0 = (int)(tot * v / G); r.p1 = (int)(tot * (v + 1) / G); return r; }
__device__ __forceinline__ bool sk_unit(const SkRange& r, int i, int& tile, int& kt0, int& nt, int& part) {
    const int e0 = min(r.p1, (r.p0 / r.hp + 1) * r.hp); const int pos = i == 0 ? r.p0 : e0 + (i - 1) * r.hp; if (pos >= r.p1) return false;
    const int end = i == 0 ? e0 : min(r.p1, pos + r.hp), a = pos % r.hp;
    tile = pos / r.hp; kt0 = 2 * a; nt = 2 * (end - pos); part = (a == 0 && end - pos == r.hp) ? 0 : (a > 0 ? 1 : 2); return true;
}
__device__ __forceinline__ void sk_publish(unsigned* flag) { asm volatile("s_waitcnt vmcnt(0)" ::: "memory"); if (lane_now() == 0) __hip_atomic_fetch_add(flag, 1u, RLX_AGENT); }
__device__ __forceinline__ void sk_wait(unsigned* flag, int wid, unsigned need = 8u) {
    if (wid == 0) { unsigned sp = 0; while ((unsigned)__builtin_amdgcn_readfirstlane(__hip_atomic_load(flag, RLX_AGENT)) < need) { __builtin_amdgcn_s_sleep(2); if (++sp > (1u << 22)) break; }
        __builtin_amdgcn_fence(__ATOMIC_ACQUIRE, "agent"); asm volatile("s_waitcnt vmcnt(0)" ::: "memory"); }
    asm volatile("" ::: "memory"); __builtin_amdgcn_s_barrier(); asm volatile("" ::: "memory");
}
__device__ __forceinline__ void st_wt16(__amdgpu_buffer_rsrc_t rsrc, unsigned voff, f32x4 v) { __builtin_amdgcn_raw_buffer_store_b128(__builtin_bit_cast(u32x4, v), rsrc, (int)voff, 0, 16); }
__device__ __forceinline__ void st_wt8(float* p, float a, float b) { __hip_atomic_store((unsigned long long*)p, ((unsigned long long)__float_as_uint(b) << 32) | __float_as_uint(a), RLX_AGENT); }

template <class Epi, class Sched>
__device__ __forceinline__ void gemm_phase(LAS unsigned char* lds, const int wid, const int lda, const int ldb, const Sched& S, const Epi& E) {
    const int lane = lane_now(), tid = wid * 64 + lane, wr = wid >> 2, wc = wid & 3, fr = lane & 15, fq = lane >> 4;
    unsigned voffA[2], voffB[2];
#pragma unroll
    for (int i = 0; i < 2; ++i) { int R, C; stage_rc(tid * 16 + i * 8192, R, C); const int Rb = Epi::PERM ? ((R & ~31) + perm32(R & 31)) : R;
        voffA[i] = (unsigned)(R * lda + C) * 2u; voffB[i] = (unsigned)(Rb * ldb + C) * 2u; }
    const size_t kstep = (size_t)(BK * 2);
    const size_t hstepA_full = (size_t)HALF * lda * 2;
    const unsigned ldsw = (unsigned)wid * 1024u;
    const int aoff = lds_byte(wr * 64 + fr, fq * 8), boff = lds_byte(wc * 32 + fr, fq * 8);
#define PG8_SA(b, h) (((b) * 2 + (h)) * HTB)
#define PG8_SB(b, h) ((4 + (b) * 2 + (h)) * HTB)
#define PG8_STAGE(bufoff, gbase, voff) do { _Pragma("unroll") for (int _i = 0; _i < 2; ++_i) \
        __builtin_amdgcn_global_load_lds((const unsigned*)((const char*)(gbase) + (voff)[_i]), (LAS unsigned*)(lds + (bufoff) + ldsw + _i * 8192), 16, 0, 0); } while (0)
#define PG8_LDA(dst, b, h) do { _Pragma("unroll") for (int m = 0; m < 4; ++m) _Pragma("unroll") for (int k = 0; k < 2; ++k) dst[m][k] = *(const LAS bf16x8*)(lds + PG8_SA(b, h) + aoff + m * 2048 + k * 1024); } while (0)
#define PG8_LDB(dst, b, h) do { _Pragma("unroll") for (int n = 0; n < 2; ++n) _Pragma("unroll") for (int k = 0; k < 2; ++k) dst[n][k] = *(const LAS bf16x8*)(lds + PG8_SB(b, h) + boff + n * 2048 + k * 1024); } while (0)
#define PG8_MMA(ai, bj, At, Bt) do { __builtin_amdgcn_s_setprio(1); _Pragma("unroll") for (int m = 0; m < 4; ++m) _Pragma("unroll") for (int n = 0; n < 2; ++n) _Pragma("unroll") for (int k = 0; k < 2; ++k) \
        acc[ai][bj][m][n] = __builtin_amdgcn_mfma_f32_16x16x32_bf16(Bt[n][k], At[m][k], acc[ai][bj][m][n], 0, 0, 0); __builtin_amdgcn_s_setprio(0); } while (0)
#define PG8_WAIT_V(n) asm volatile("s_waitcnt vmcnt(" #n ")" ::: "memory")
#define PG8_WAIT_L(n) asm volatile("s_waitcnt lgkmcnt(" #n ")" ::: "memory")
#define PG8_BAR __builtin_amdgcn_s_barrier()
#define PG8_SCHED __builtin_amdgcn_sched_barrier(0)
    Unit cur, nxt; int ui = 0;
    if (!S.next(0, cur)) return;
    f32x4 acc[2][2][4][2];
#pragma unroll
    for (int a = 0; a < 2; ++a)
#pragma unroll
        for (int b = 0; b < 2; ++b)
#pragma unroll
            for (int m = 0; m < 4; ++m)
#pragma unroll
                for (int n = 0; n < 2; ++n) acc[a][b][m][n] = (f32x4){0.f, 0.f, 0.f, 0.f};
    bf16x8 At[4][2], B0[2][2], B1[2][2];
    const char* cA = S.a_ptr(cur) + (cur.half == 2 ? hstepA_full : 0); const char* cB0 = S.b_ptr(cur, 0); const char* cB1 = S.b_ptr(cur, 1);
    size_t hstepA = cur.half ? 0 : hstepA_full;
    PG8_STAGE(PG8_SB(0, 0), cB0, voffB); PG8_STAGE(PG8_SB(0, 1), cB1, voffB); PG8_STAGE(PG8_SA(0, 0), cA, voffA); PG8_STAGE(PG8_SA(0, 1), cA + hstepA, voffA);
    if (wr == 1) PG8_BAR;
    PG8_WAIT_V(2); PG8_BAR;
    PG8_STAGE(PG8_SB(1, 0), cB0 + kstep, voffB); PG8_STAGE(PG8_SA(1, 0), cA + kstep, voffA); PG8_STAGE(PG8_SB(1, 1), cB1 + kstep, voffB);
    PG8_WAIT_V(6); PG8_BAR;
    for (;;) {
        const bool has_next = S.next(ui + 1, nxt);
        const char* nA = has_next ? S.a_ptr(nxt) + (nxt.half == 2 ? hstepA_full : 0) : cA; const char* nB0 = has_next ? S.b_ptr(nxt, 0) : cB0; const char* nB1 = has_next ? S.b_ptr(nxt, 1) : cB1;
        const size_t nhs = has_next ? (nxt.half ? 0 : hstepA_full) : hstepA; const bool whole = (cur.half == 0), wholeN = (cur.nhalf == 0);
        const int nt = cur.nt;
        for (int t = 0; t < nt; t += 2) {
            const bool last = (t == nt - 2);
            const char* a1 = cA + (size_t)(t + 1) * kstep;
            const char* a2 = last ? nA : cA + (size_t)(t + 2) * kstep;
            const char* b20 = last ? nB0 : cB0 + (size_t)(t + 2) * kstep; const char* b21 = last ? nB1 : cB1 + (size_t)(t + 2) * kstep;
            const char* a3 = a2 + kstep; const char* b30 = b20 + kstep; const char* b31 = b21 + kstep;
            PG8_LDB(B0, 0, 0); PG8_LDB(B1, 0, 1); PG8_SCHED; PG8_LDA(At, 0, 0); PG8_STAGE(PG8_SA(1, 1), a1 + hstepA, voffA);
            PG8_WAIT_V(8); PG8_WAIT_L(0); PG8_BAR; PG8_MMA(0, 0, At, B0); if (wholeN) { PG8_MMA(0, 1, At, B1); } PG8_BAR; PG8_SCHED;
            PG8_LDA(At, 0, 1); PG8_STAGE(PG8_SB(0, 0), b20, voffB); PG8_STAGE(PG8_SB(0, 1), b21, voffB); PG8_STAGE(PG8_SA(0, 0), a2, voffA);
            PG8_WAIT_V(8); PG8_WAIT_L(0); PG8_BAR; if (whole) { PG8_MMA(1, 0, At, B0); if (wholeN) { PG8_MMA(1, 1, At, B1); } } PG8_BAR; PG8_SCHED;
            PG8_LDB(B0, 1, 0); PG8_LDB(B1, 1, 1); PG8_SCHED; PG8_LDA(At, 1, 0); PG8_STAGE(PG8_SA(0, 1), a2 + (last ? nhs : hstepA), voffA);
            PG8_WAIT_V(8); PG8_WAIT_L(0); PG8_BAR; PG8_MMA(0, 0, At, B0); if (wholeN) { PG8_MMA(0, 1, At, B1); } PG8_BAR; PG8_SCHED;
            PG8_LDA(At, 1, 1); PG8_STAGE(PG8_SB(1, 0), b30, voffB); PG8_STAGE(PG8_SB(1, 1), b31, voffB); PG8_STAGE(PG8_SA(1, 0), a3, voffA);
            PG8_WAIT_V(8); PG8_WAIT_L(0); PG8_BAR; if (whole) { PG8_MMA(1, 0, At, B0); if (wholeN) { PG8_MMA(1, 1, At, B1); } } PG8_BAR; PG8_SCHED;
        }
        if (wr == 0) PG8_BAR;
        E(acc, cur, wr, wc, wid);
        if (!has_next) break;
#pragma unroll
        for (int a = 0; a < 2; ++a)
#pragma unroll
            for (int b = 0; b < 2; ++b)
#pragma unroll
                for (int m = 0; m < 4; ++m)
#pragma unroll
                    for (int n = 0; n < 2; ++n) acc[a][b][m][n] = (f32x4){0.f, 0.f, 0.f, 0.f};
        cur = nxt; cA = nA; cB0 = nB0; cB1 = nB1; hstepA = nhs; ++ui;
        if (wr == 1) PG8_BAR;
    }
    PG8_WAIT_V(0);
    PG8_BAR;
#undef PG8_SA
#undef PG8_SB
#undef PG8_STAGE
#undef PG8_LDA
#undef PG8_LDB
#undef PG8_MMA
#undef PG8_WAIT_V
#undef PG8_WAIT_L
#undef PG8_BAR
#undef PG8_SCHED
}
}
struct Ptrs {
    const float *x_prompt, *x_sample, *cache_lat, *cache_krope, *state_gla, *cache_conv, *meta, *g_mix, *w_in, *w_a2, *b_a, *g_gla, *g_q, *w_uq, *g_kv, *w_uk, *w_uv, *w_o, *g_ffn, *w_up, *conv_w, *conv_b, *w_down, *final_norm;
    float* out; unsigned char* ws;
};
#define WSP(T, off) ((T*)(P.ws + (off)))

struct TileOrder {
    int nM, nN, nwg, G, c;
    __device__ __forceinline__ void init(int nM_, int nN_, int G_, int c_) { nM = nM_; nN = nN_; nwg = nM * nN; G = G_; c = c_; }
    __device__ __forceinline__ bool map(int i, int& pm, int& pn) const { return map_L((long)i * G + c, pm, pn); }
    __device__ __forceinline__ bool map_L(long L, int& pm, int& pn) const {
        if (L >= nwg) return false;
        int wgid = (int)L; { const int q = nwg / 8, r = nwg % 8, xcd = wgid % 8, off = wgid / 8; wgid = (xcd < r ? xcd * (q + 1) : r * (q + 1) + (xcd - r) * q) + off; }
        const int nig = 8 * nN, gid = wgid / nig, fm = gid * 8, gsz = (nM - fm) < 8 ? (nM - fm) : 8;
        pm = fm + ((wgid % nig) % gsz); pn = (wgid % nig) / gsz; return true;
    }
};
struct SchedPlain {
    TileOrder o; const char* A; const char* Bt; size_t a_tile, b_tile;
    int nt;
    int quarter = 0;
    __device__ __forceinline__ bool next(int i, pg8::Unit& u) const { u.kind = 0; u.nt = nt; u.part = 0; u.half = 0; u.nhalf = 0;
        const long L = (long)i * o.G + o.c; const long nfull = (long)(o.nwg / o.G) * o.G;
        if (L < nfull) return o.map_L(L, u.pm, u.pn);
        const long L2 = L - nfull;
        if (2 * (o.nwg - nfull) > o.G) return o.map_L(L, u.pm, u.pn);
        if (quarter) { u.half = 1 + (int)(L2 & 1); u.nhalf = 1 + (int)((L2 >> 1) & 1); return o.map_L(nfull + (L2 >> 2), u.pm, u.pn); }
        u.half = 1 + (int)(L2 & 1); return o.map_L(nfull + (L2 >> 1), u.pm, u.pn); }
    __device__ __forceinline__ const char* a_ptr(const pg8::Unit& u) const { return A + (size_t)u.pm * a_tile; }
    __device__ __forceinline__ const char* b_ptr(const pg8::Unit& u, int h) const { return Bt + (size_t)u.pn * b_tile + (size_t)(u.nhalf ? u.nhalf - 1 : h) * (b_tile >> 1); }
};
struct SchedSK {
    pg8::SkRange r; int nN; const char* A; const char* Bt; size_t a_tile, b_tile;
    __device__ __forceinline__ bool next(int i, pg8::Unit& u) const { int tile, kt0; u.half = 0; u.nhalf = 0; if (!pg8::sk_unit(r, i, tile, kt0, u.nt, u.part)) return false; u.pm = tile / nN; u.pn = tile - u.pm * nN; u.kind = kt0; return true; }
    __device__ __forceinline__ const char* a_ptr(const pg8::Unit& u) const { return A + (size_t)u.pm * a_tile + (size_t)u.kind * 128; }
    __device__ __forceinline__ const char* b_ptr(const pg8::Unit& u, int h) const { return Bt + (size_t)u.pn * b_tile + (size_t)h * (b_tile >> 1) + (size_t)u.kind * 128; }
};
template <int NS>
struct SchedSplitTail {
    TileOrder o; const char* A; const char* Bt; size_t a_tile, b_tile; int nt;
    __device__ __forceinline__ bool next(int i, pg8::Unit& u) const {
        u.half = 0; u.nhalf = 0; if (i == 0) { u.kind = 0; u.nt = nt; u.part = 0; return o.map(0, u.pm, u.pn); }
        if (i > 1) return false;
        const int t = o.G + o.c / NS; if (t >= o.nwg) return false;
        const int q = o.c % NS; TileOrder o2 = o; o2.c = t; o2.G = 0; o2.map(0, u.pm, u.pn); u.nt = nt / NS; u.kind = q * (nt / NS); u.part = 1 + q; return true;
    }
    __device__ __forceinline__ const char* a_ptr(const pg8::Unit& u) const { return A + (size_t)u.pm * a_tile + (size_t)u.kind * 128; }
    __device__ __forceinline__ const char* b_ptr(const pg8::Unit& u, int h) const { return Bt + (size_t)u.pn * b_tile + (size_t)h * (b_tile >> 1) + (size_t)u.kind * 128; }
};
struct SchedP2 {
    int G, c; const char* ws;
    __device__ __forceinline__ bool next(int i, pg8::Unit& u) const {
        int L = i * G + c; u.nt = 8; u.part = 0; u.half = 0; u.nhalf = 0;
        if (L < 420) { u.kind = 0; u.pm = L / 12; u.pn = L % 12; return true; } L -= 420;
        if (L < 528) { u.kind = 1; const int t = L >> 4; u.pm = t < 32 ? t : 34; u.pn = L & 15; return true; } L -= 528;
        if (L < 64) { u.kind = 2; u.pm = 32 + (L >> 5); u.pn = L & 31; return true; }
        return false;
    }
    __device__ __forceinline__ const char* a_ptr(const pg8::Unit& u) const { return ws + WS_H + ((size_t)u.pm * 256 * NH + (u.kind == 1 ? HC_CKV : HC_CQ)) * 2; }
    __device__ __forceinline__ const char* b_ptr(const pg8::Unit& u, int h) const { const size_t off = u.kind == 0 ? WS_WQT : (u.kind == 1 ? WS_WKVT : WS_WABS); return ws + off + ((size_t)u.pn * 256 + h * 128) * 512 * 2; }
};
struct SchedWabs {
    int G, c; const char* WUKN; const char* WUQN;
    __device__ __forceinline__ bool next(int i, pg8::Unit& u) const { const int L = i * G + c; if (L >= 64) return false; u.nt = 2; u.part = 0; u.half = 0; u.nhalf = 0; u.kind = 3 + (L >> 2); u.pm = (L >> 1) & 1; u.pn = L & 1; return true; }
    __device__ __forceinline__ const char* a_ptr(const pg8::Unit& u) const { return WUKN + ((size_t)u.pm * 256 * 2048 + (u.kind - 3) * 128) * 2; }
    __device__ __forceinline__ const char* b_ptr(const pg8::Unit& u, int h) const { return WUQN + (((size_t)u.pn * 256 + h * 128) * 3072 + (u.kind - 3) * 192) * 2; }
};

struct EpiInProj {
    static constexpr bool PERM = true;
    bf16_t* H; const float* rsx; float* ss;
    __device__ __forceinline__ void operator()(const pg8::Acc& acc, const pg8::Unit& u, int wr, int wc, int wid) const {
        const int lane_ = lane_now(), fr = lane_ & 15, fq = lane_ >> 4;
        const int row0 = u.pm * 256 + wr * 64 + fr + (u.half == 2 ? 128 : 0), col0 = u.pn * 256 + wc * 32 + 8 * fq;
        const bool stats = (u.pn >= 24 && u.pn < 28);
#pragma unroll
        for (int ai = 0; ai < 2; ++ai) if (ai == 0 || !u.half)
#pragma unroll
            for (int m = 0; m < 4; ++m) {
                const int row = row0 + ai * 128 + m * 16; const float rs = rsx[row]; float sq = 0.f;
#pragma unroll
                for (int bj = 0; bj < 2; ++bj) { const f32x4 v0 = acc[ai][bj][m][0] * rs, v1 = acc[ai][bj][m][1] * rs;
                    sq += (v0[0] * v0[0] + v0[1] * v0[1]) + (v0[2] * v0[2] + v0[3] * v0[3]) + (v1[0] * v1[0] + v1[1] * v1[1]) + (v1[2] * v1[2] + v1[3] * v1[3]);
                    u32x4 w; w.x = pk2(v0[0], v0[1]); w.y = pk2(v0[2], v0[3]); w.z = pk2(v1[0], v1[1]); w.w = pk2(v1[2], v1[3]);
                    *(u32x4*)(H + (size_t)row * NH + col0 + bj * 128) = w; }
                if (stats) { sq += __shfl_xor(sq, 16); sq += __shfl_xor(sq, 32); if (fq == 0) ss[row * 16 + (u.pn - 24) * 4 + wc] = sq; }
            }
    }
};
struct EpiP2 {
    static constexpr bool PERM = true;
    bf16_t *Q, *KV, *QLAT, *WABS; const float* ss; const f32x2* rope;
    __device__ __forceinline__ void operator()(const pg8::Acc& acc, const pg8::Unit& u, int wr, int wc, int wid) const {
        const int lane_ = lane_now(), fr = lane_ & 15, fq = lane_ >> 4;
        const int rl0 = wr * 64 + fr + (u.half == 2 ? 128 : 0), cl0 = wc * 32 + 8 * fq;
        bf16_t* dst; int ldc; int mode;
        if (u.kind == 0) { dst = Q + (size_t)u.pm * 256 * QP + u.pn * 256; ldc = QP; mode = 0; }
        else if (u.kind == 1) { dst = KV + (size_t)(u.pm < 32 ? u.pm : 32) * 256 * 4096 + u.pn * 256; ldc = 4096; mode = 1; }
        else if (u.kind == 2) { dst = QLAT + (size_t)(u.pm - 32) * 256 * 8192 + u.pn * 256; ldc = 8192; mode = 0; }
        else { dst = WABS + ((size_t)(u.kind - 3) * 512 + u.pm * 256) * 512 + u.pn * 256; ldc = 512; mode = 2; }
        const bool do_rope = (u.kind == 0 && u.pn >= 8);
#pragma unroll
        for (int ai = 0; ai < 2; ++ai) if (ai == 0 || !u.half)
#pragma unroll
            for (int m = 0; m < 4; ++m) {
                const int rl = rl0 + ai * 128 + m * 16, row = u.pm * 256 + rl; float sc = 1.f;
                if (mode != 2) { const f32x4* sp = (const f32x4*)(ss + row * 16 + (mode == 1 ? 8 : 0)); const f32x4 a = sp[0], b = sp[1];
                    sc = __builtin_amdgcn_rsqf(((a[0] + a[1]) + (a[2] + a[3]) + (b[0] + b[1]) + (b[2] + b[3])) * (1.f / 512.f) + EPS); if (mode == 0) sc *= QSCALE; }
#pragma unroll
                for (int bj = 0; bj < 2; ++bj) { f32x4 v0 = acc[ai][bj][m][0] * sc, v1 = acc[ai][bj][m][1] * sc;
                    if (do_rope) { const int i0 = ((u.pn * 256 + bj * 128 + cl0) & 63) >> 1; const f32x4* rp = (const f32x4*)(rope + (size_t)row * 32 + i0); const f32x4 c0 = rp[0], c1 = rp[1];
                        f32x4 t0, t1; t0[0] = v0[0] * c0[0] - v0[1] * c0[1]; t0[1] = v0[1] * c0[0] + v0[0] * c0[1]; t0[2] = v0[2] * c0[2] - v0[3] * c0[3]; t0[3] = v0[3] * c0[2] + v0[2] * c0[3];
                        t1[0] = v1[0] * c1[0] - v1[1] * c1[1]; t1[1] = v1[1] * c1[0] + v1[0] * c1[1]; t1[2] = v1[2] * c1[2] - v1[3] * c1[3]; t1[3] = v1[3] * c1[2] + v1[2] * c1[3]; v0 = t0; v1 = t1; }
                    u32x4 w; w.x = pk2(v0[0], v0[1]); w.y = pk2(v0[2], v0[3]); w.z = pk2(v1[0], v1[1]); w.w = pk2(v1[2], v1[3]);
                    *(u32x4*)(dst + (size_t)rl * ldc + bj * 128 + cl0) = w; }
            }
    }
};
struct EpiWabs {
    static constexpr bool PERM = true;
    bf16_t* WABS;
    __device__ __forceinline__ void operator()(const pg8::Acc& acc, const pg8::Unit& u, int wr, int wc, int wid) const {
        const int lane_ = lane_now(), fr = lane_ & 15, fq = lane_ >> 4;
        bf16_t* dst = WABS + ((size_t)(u.kind - 3) * 512 + u.pm * 256 + wr * 64 + fr) * 512 + u.pn * 256 + wc * 32 + 8 * fq;
#pragma unroll
        for (int ai = 0; ai < 2; ++ai) if (ai == 0 || !u.half)
#pragma unroll
            for (int m = 0; m < 4; ++m)
#pragma unroll
                for (int bj = 0; bj < 2; ++bj) { const f32x4 v0 = acc[ai][bj][m][0], v1 = acc[ai][bj][m][1];
                    u32x4 w; w.x = pk2(v0[0], v0[1]); w.y = pk2(v0[2], v0[3]); w.z = pk2(v1[0], v1[1]); w.w = pk2(v1[2], v1[3]);
                    *(u32x4*)(dst + (size_t)(ai * 128 + m * 16) * 512 + bj * 128) = w; }
    }
};
struct EpiOut {
    static constexpr bool PERM = false;
    const float *xp, *xs, *meta; float* dout; float* x2m; bf16_t* x2b; float* ss2; unsigned* flags;
    __device__ __forceinline__ void operator()(const pg8::Acc& acc, const pg8::Unit& u, int wr, int wc, int wid) const {
        const int lane_ = lane_now(), fr = lane_ & 15, fq = lane_ >> 4;
        const int rl0 = wr * 64 + fr + (u.half == 2 ? 128 : 0), c0 = u.pn * 256 + wc * 32 + 4 * fq;
        const float* xb = u.pm < 32 ? xp + (size_t)u.pm * 256 * DM : (u.pm < 34 ? xs + (size_t)(u.pm - 32) * 256 * DM : meta);
        float* ob = u.pm < 34 ? dout + (size_t)u.pm * 256 * DM : x2m;
        unsigned* flag = flags + u.pm * 8 + u.pn;
        if (u.part == 2) pg8::sk_wait(flag, wid);
#pragma unroll
        for (int ai = 0; ai < 2; ++ai) if (ai == 0 || !u.half)
#pragma unroll
            for (int m = 0; m < 4; ++m) {
                const int rl = rl0 + ai * 128 + m * 16, row = u.pm * 256 + rl; const bool xv = (u.pm < 34) || (rl < 16); float sq = 0.f;
#pragma unroll
                for (int bj = 0; bj < 2; ++bj)
#pragma unroll
                    for (int n = 0; n < 2; ++n) { const int c = c0 + bj * 128 + n * 16;
                        f32x4 xx = (f32x4){0.f, 0.f, 0.f, 0.f};
                        if (u.part == 2) xx = *(const f32x4*)(ob + (size_t)rl * DM + c); else if (xv) xx = *(const f32x4*)(xb + (size_t)rl * DM + c);
                        const f32x4 v = xx + acc[ai][bj][m][n];
                        if (u.part == 1) { *(f32x4*)(ob + (size_t)rl * DM + c) = v; }
                        else { sq += (v[0] * v[0] + v[1] * v[1]) + (v[2] * v[2] + v[3] * v[3]);
                            *(f32x4*)(ob + (size_t)rl * DM + c) = v;
                            u32x2 w; w.x = pk2(v[0], v[1]); w.y = pk2(v[2], v[3]); *(u32x2*)(x2b + (size_t)row * DM + c) = w; } }
                if (u.part != 1) { sq += __shfl_xor(sq, 16); sq += __shfl_xor(sq, 32); if (fq == 0) ss2[row * 32 + u.pn * 4 + wc] = sq; }
            }
        if (u.part == 1) pg8::sk_publish(flag);
    }
};
struct EpiUp {
    static constexpr bool PERM = true;
    bf16_t* U;
    __device__ __forceinline__ void operator()(const pg8::Acc& acc, const pg8::Unit& u, int wr, int wc, int wid) const {
        const int lane_ = lane_now(), fr = lane_ & 15, fq = lane_ >> 4;
        const int row0 = u.pm * 256 + wr * 64 + fr + (u.half == 2 ? 128 : 0), col0 = u.pn * 256 + wc * 32 + 8 * fq + (u.nhalf == 2 ? 128 : 0);
#pragma unroll
        for (int ai = 0; ai < 2; ++ai) if (ai == 0 || !u.half)
#pragma unroll
            for (int m = 0; m < 4; ++m) { const int row = row0 + ai * 128 + m * 16;
#pragma unroll
                for (int bj = 0; bj < 2; ++bj) if (bj == 0 || !u.nhalf) { const f32x4 v0 = acc[ai][bj][m][0], v1 = acc[ai][bj][m][1];
                    u32x4 w; w.x = pk2(v0[0], v0[1]); w.y = pk2(v0[2], v0[3]); w.z = pk2(v1[0], v1[1]); w.w = pk2(v1[2], v1[3]);
                    *(u32x4*)(U + (size_t)row * DFF2 + col0 + bj * 128) = w; } }
    }
};
struct EpiDown {
    static constexpr bool PERM = false; static constexpr int NS = 4;
    float* dout; unsigned* flags; LAS unsigned char* lds;
    __device__ __forceinline__ void operator()(const pg8::Acc& acc, const pg8::Unit& u, int wr, int wc, int wid) const {
        const int lane_ = lane_now(), fr = lane_ & 15, fq = lane_ >> 4;
        float* tb = dout + (size_t)u.pm * 256 * DM + u.pn * 256;
        if (u.part > 0) {
            asm volatile("s_waitcnt vmcnt(0)" ::: "memory"); __builtin_amdgcn_s_barrier(); asm volatile("" ::: "memory");
            LAS float* wl = (LAS float*)(lds + wid * 17408);
#pragma unroll
            for (int ai = 0; ai < 2; ++ai) {
#pragma unroll
                for (int m = 0; m < 4; ++m)
#pragma unroll
                    for (int bj = 0; bj < 2; ++bj)
#pragma unroll
                        for (int n = 0; n < 2; ++n) *(LAS f32x4*)(wl + (m * 16 + fr) * 68 + bj * 32 + n * 16 + 4 * fq) = acc[ai][bj][m][n];
                asm volatile("s_waitcnt lgkmcnt(0)" ::: "memory");
                float* gp = tb + (size_t)(ai * 128 + wr * 64) * DM + (lane_ < 32 ? wc * 32 + lane_ : 128 + wc * 32 + (lane_ - 32));
#pragma unroll 8
                for (int rr = 0; rr < 64; ++rr) atomicAdd(gp + (size_t)rr * DM, wl[rr * 68 + lane_]);
                asm volatile("s_waitcnt lgkmcnt(0)" ::: "memory"); }
            return; }
        const unsigned lo = (unsigned)((wr * 64 + fr + (u.half == 2 ? 128 : 0)) * DM + wc * 32 + 4 * fq + (u.nhalf == 2 ? 128 : 0)) * 4u;
#pragma unroll
        for (int ai = 0; ai < 2; ++ai) if (ai == 0 || !u.half)
#pragma unroll
            for (int m = 0; m < 4; ++m)
#pragma unroll
                for (int bj = 0; bj < 2; ++bj) if (bj == 0 || !u.nhalf)
#pragma unroll
                    for (int n = 0; n < 2; ++n) { const unsigned off = lo + (unsigned)((ai * 128 + m * 16) * DM + bj * 128 + n * 16) * 4u; *(f32x4*)((char*)tb + off) = *(const f32x4*)((const char*)tb + off) + acc[ai][bj][m][n]; }
    }
};
struct WaveCtx { LAS unsigned char* lds; int wave, gw, ngw; };

#define LDS_WAIT() asm volatile("s_waitcnt lgkmcnt(0)" ::: "memory")
constexpr int TR_P = 144;
template <class ColMap>
__device__ __forceinline__ void transpose_item(const float* __restrict__ W, int K, int Nsrc, const float* __restrict__ gain, bf16_t* __restrict__ WT, LAS unsigned char* scr, int item, int nblk, int lane, const ColMap& cm) {
    const int kb = item / nblk, nb = item - kb * nblk, k0 = 64 * kb, n0 = 64 * nb, kr = lane >> 4, n4 = (lane & 15) * 4;
    const int sc = cm(n0 + n4); const bool contig = (sc >= 0) && (cm(n0 + n4 + 3) == sc + 3);
    f32x4 v[16];
    if (contig) {
#pragma unroll
        for (int i = 0; i < 16; ++i) v[i] = *(const f32x4*)(W + (size_t)(k0 + kr + 4 * i) * Nsrc + sc);
    } else { const int s1 = cm(n0 + n4 + 1), s2 = cm(n0 + n4 + 2), s3 = cm(n0 + n4 + 3);
#pragma unroll
        for (int i = 0; i < 16; ++i) { const float* wr = W + (size_t)(k0 + kr + 4 * i) * Nsrc; v[i] = (f32x4){sc >= 0 ? wr[sc] : 0.f, s1 >= 0 ? wr[s1] : 0.f, s2 >= 0 ? wr[s2] : 0.f, s3 >= 0 ? wr[s3] : 0.f}; } }
#pragma unroll
    for (int i = 0; i < 16; ++i) { const float gk = gain ? gain[k0 + kr + 4 * i] : 1.f; u32x2 w; w.x = pk2(v[i][0] * gk, v[i][1] * gk); w.y = pk2(v[i][2] * gk, v[i][3] * gk);
        *(LAS u32x2*)(scr + (kr + 4 * i) * TR_P + n4 * 2) = w; }
    LDS_WAIT(); asm volatile("" ::: "memory");
    const int gi = lane >> 4, li = lane & 15; LAS const unsigned char* rb = scr + (li >> 2) * TR_P + (16 * gi + 4 * (li & 3)) * 2;
    bf16_t* wo = WT + (size_t)(n0 + 16 * gi + li) * K + k0;
#pragma unroll
    for (int c = 0; c < 8; ++c) { const s16x4 lo = lds_tr(rb + (8 * c) * TR_P), hi = lds_tr(rb + (8 * c + 4) * TR_P); *(bf16x8*)(wo + 8 * c) = cat8(lo, hi); }
    LDS_WAIT(); asm volatile("" ::: "memory");
}
struct MapIn {
    __device__ __forceinline__ int operator()(int n) const {
        if (n < 6144) return n;
        if (n < 6656) return 6160 + (n - 6144);
        if (n < 7168) return 6672 + (n - 6656);
        if (n < 9216) return 7248 + (n - 7168);
        if (n < 11264) return 9296 + (n - 9216);
        if (n < 11328) { const int j = n - 11264, i = j >> 1; return 7184 + ((j & 1) ? i + 32 : i); }
        if (n < 11344) return 6144 + (n - 11328);
        return -1; }
};
struct MapQ {
    __device__ __forceinline__ int operator()(int n) const {
        if (n < 2048) return (n >> 7) * 192 + (n & 127);
        const int j = n - 2048, h = j >> 6, jj = j & 63, i = jj >> 1; return h * 192 + 128 + ((jj & 1) ? i + 32 : i); }
};
struct MapId { __device__ __forceinline__ int operator()(int n) const { return n; } };
struct MapOff { int off; __device__ __forceinline__ int operator()(int n) const { return n - off; } };

__device__ __forceinline__ void unpack8bf(const u32x4 w, float (&v)[8]) { v[0] = bflo(w.x); v[1] = bfhi(w.x); v[2] = bflo(w.y); v[3] = bfhi(w.y); v[4] = bflo(w.z); v[5] = bfhi(w.z); v[6] = bflo(w.w); v[7] = bfhi(w.w); }
__device__ __forceinline__ void load8bf(const bf16_t* p, float (&v)[8]) { const u32x4 w = *(const u32x4*)p; v[0] = bflo(w.x); v[1] = bfhi(w.x); v[2] = bflo(w.y); v[3] = bfhi(w.y); v[4] = bflo(w.z); v[5] = bfhi(w.z); v[6] = bflo(w.w); v[7] = bfhi(w.w); }
__device__ __forceinline__ u32x4 pack8(const float (&v)[8]) { u32x4 w; w.x = pk2(v[0], v[1]); w.y = pk2(v[2], v[3]); w.z = pk2(v[4], v[5]); w.w = pk2(v[6], v[7]); return w; }

__device__ __forceinline__ void p0_prologue(const Ptrs& P, const WaveCtx& C) {
    const int lane = lane_now();
    LAS unsigned char* scr = C.lds + C.wave * 16384;
    constexpr int I_IN = 32 * 180, I_Q = 8 * 48, I_KV = 8 * 32, I_O = 32 * 32, I_UV = 8 * 32;
    constexpr int NITEMS = I_IN + I_Q + 2 * I_KV + I_O + I_UV;
#ifdef PROBE_P0A
    const unsigned long long tp0_ = __builtin_amdgcn_s_memrealtime();
#endif
    for (int it = C.gw; it < NITEMS; it += C.ngw) {
        int r = it;
        if (r < I_IN) { transpose_item(P.w_in, DM, IN_COLS, P.g_mix, WSP(bf16_t, WS_W1T), scr, r, 180, lane, MapIn()); continue; } r -= I_IN;
        if (r < I_Q) { transpose_item(P.w_uq, 512, 3072, P.g_q, WSP(bf16_t, WS_WQT), scr, r, 48, lane, MapQ()); continue; } r -= I_Q;
        if (r < I_KV) { transpose_item(P.w_uk, 512, 2048, P.g_kv, WSP(bf16_t, WS_WKVT), scr, r, 32, lane, MapId()); continue; } r -= I_KV;
        if (r < I_KV) { transpose_item(P.w_uv, 512, 2048, P.g_kv, WSP(bf16_t, WS_WKVT) + (size_t)2048 * 512, scr, r, 32, lane, MapId()); continue; } r -= I_KV;
        if (r < I_O) { transpose_item(P.w_o, DM, DM, nullptr, WSP(bf16_t, WS_WOT), scr, r, 32, lane, MapId()); continue; } r -= I_O;
        transpose_item(P.w_uv, 512, 2048, nullptr, WSP(bf16_t, WS_WUVT), scr, r, 32, lane, MapId());
    }
    { const int nth = C.ngw * 64, t0 = C.gw * 64 + lane;
      for (int i = t0; i < 512 * 2048 / 4; i += nth) { const f32x4 v = *(const f32x4*)(P.w_uk + (size_t)i * 4); u32x2 w; w.x = pk2(v[0], v[1]); w.y = pk2(v[2], v[3]); *(u32x2*)(WSP(bf16_t, WS_WUKN) + (size_t)i * 4) = w; }
      for (int i = t0; i < 512 * 3072 / 4; i += nth) { const f32x4 v = *(const f32x4*)(P.w_uq + (size_t)i * 4) * P.g_q[(i * 4) / 3072]; u32x2 w; w.x = pk2(v[0], v[1]); w.y = pk2(v[2], v[3]); *(u32x2*)(WSP(bf16_t, WS_WUQN) + (size_t)i * 4) = w; } }
#ifdef PROBE_P0A
    { const unsigned long long tp1_ = __builtin_amdgcn_s_memrealtime(); while (__builtin_amdgcn_s_memrealtime() - tp1_ < tp1_ - tp0_) __builtin_amdgcn_s_sleep(8); }
#endif
#ifdef PROBE_P0B
    const unsigned long long tq0_ = __builtin_amdgcn_s_memrealtime();
#endif
    for (int row = C.gw; row < M_PAD; row += C.ngw) {
        const float* src = row < R_SAMPLE ? P.x_prompt + (size_t)row * DM : (row < R_META ? P.x_sample + (size_t)(row - R_SAMPLE) * DM : (row < M_REAL ? P.meta + (size_t)(row - R_META) * DM : nullptr));
        bf16_t* dst = WSP(bf16_t, WS_XBF) + (size_t)row * DM;
        if (src) { f32x4 v[8]; float s = 0.f;
#pragma unroll
            for (int j = 0; j < 8; ++j) { v[j] = *(const f32x4*)(src + (j * 64 + lane) * 4); s += (v[j][0] * v[j][0] + v[j][1] * v[j][1]) + (v[j][2] * v[j][2] + v[j][3] * v[j][3]); }
            s = wave_sum(s);
#pragma unroll
            for (int j = 0; j < 8; ++j) { u32x2 w; w.x = pk2(v[j][0], v[j][1]); w.y = pk2(v[j][2], v[j][3]); *(u32x2*)(dst + (j * 64 + lane) * 4) = w; }
            if (lane == 0) WSP(float, WS_RSX)[row] = __builtin_amdgcn_rsqf(s * (1.f / DM) + EPS);
        } else {
#pragma unroll
            for (int j = 0; j < 8; ++j) *(u32x2*)(dst + (j * 64 + lane) * 4) = (u32x2){0u, 0u};
            if (lane == 0) WSP(float, WS_RSX)[row] = 0.f;
        }
        if (lane < 32) { const int pos = row < R_SAMPLE ? row + N_META : (row < R_META ? PAST + ((row - R_SAMPLE) & 15) : (row < M_REAL ? row - R_META : 0));
            double inv = 1.0; for (int k = 0; k < lane; ++k) inv *= 0.74989420933245582730;
            const double ang = (double)pos * inv, qd = __builtin_rint(ang * 0.63661977236758134308), r = (ang - qd * 1.57079632679489655800) - qd * 6.12323399573676603587e-17, r2 = r * r;
            const double sn = r * (1.0 + r2 * (-1.0 / 6 + r2 * (1.0 / 120 + r2 * (-1.0 / 5040 + r2 * (1.0 / 362880 + r2 * (-1.0 / 39916800 + r2 * (1.0 / 6227020800.0)))))));
            const double cs = 1.0 + r2 * (-0.5 + r2 * (1.0 / 24 + r2 * (-1.0 / 720 + r2 * (1.0 / 40320 + r2 * (-1.0 / 3628800 + r2 * (1.0 / 479001600.0 + r2 * (-1.0 / 87178291200.0)))))));
            const int qi = ((int)qd) & 3; const double sv = (qi == 0) ? sn : (qi == 1) ? cs : (qi == 2) ? -sn : -cs, cv = (qi == 0) ? cs : (qi == 1) ? -sn : (qi == 2) ? -cs : sn;
            WSP(f32x2, WS_ROPE)[(size_t)row * 32 + lane] = (f32x2){(float)cv, (float)sv}; }
    }
#ifdef PROBE_P0B
    { const unsigned long long tq1_ = __builtin_amdgcn_s_memrealtime(); while (__builtin_amdgcn_s_memrealtime() - tq1_ < tq1_ - tq0_) __builtin_amdgcn_s_sleep(8); }
#endif
}

__device__ __forceinline__ void p1_wabs(const Ptrs& P, const WaveCtx& C) {
    const int lane = lane_now(), r32 = lane & 31, hi = lane >> 5;
    const bf16_t* A = WSP(bf16_t, WS_WUKN); const bf16_t* B = WSP(bf16_t, WS_WUQN); bf16_t* W = WSP(bf16_t, WS_WABS);
    for (int it = C.gw; it < 4096; it += C.ngw) { const int h = it >> 8, jb = (it >> 4) & 15, kb = it & 15;
        const bf16_t* ap = A + (size_t)(32 * jb + r32) * 2048 + h * 128 + 8 * hi; const bf16_t* bp = B + (size_t)(32 * kb + r32) * 3072 + h * 192 + 8 * hi;
        f32x16 c = (f32x16){0.f, 0.f, 0.f, 0.f, 0.f, 0.f, 0.f, 0.f, 0.f, 0.f, 0.f, 0.f, 0.f, 0.f, 0.f, 0.f};
#pragma unroll
        for (int ks = 0; ks < 8; ++ks) c = MFMA32(*(const bf16x8*)(ap + 16 * ks), *(const bf16x8*)(bp + 16 * ks), c);
        bf16_t* wp = W + ((size_t)h * 512 + 32 * jb + 4 * hi) * 512 + 32 * kb + r32;
#pragma unroll
        for (int r = 0; r < 16; ++r) wp[(size_t)((r & 3) + 8 * (r >> 2)) * 512] = f2bf(c[r]); }
}

constexpr int I_CACHE = DEC_B * PAST / 4;
__device__ __forceinline__ void cache_conv_item(const Ptrs& P, int item, int lane) {
    f32x4 a[4], bb[4]; float k1[4], k2[4];
#pragma unroll
    for (int q = 0; q < 4; ++q) { const int it = item * 4 + q; const float* ls = P.cache_lat + (size_t)it * 512 + 8 * lane; a[q] = *(const f32x4*)ls; bb[q] = *(const f32x4*)(ls + 4);
        if (lane < 32) { const float* ks = P.cache_krope + (size_t)it * 64; k1[q] = ks[lane]; k2[q] = ks[lane + 32]; } }
#pragma unroll
    for (int q = 0; q < 4; ++q) { const int it = item * 4 + q; const int b = it >> 10, p = it & 1023;
        u32x4 w; w.x = pk2(a[q][0], a[q][1]); w.y = pk2(a[q][2], a[q][3]); w.z = pk2(bb[q][0], bb[q][1]); w.w = pk2(bb[q][2], bb[q][3]);
        *(u32x4*)(WSP(bf16_t, WS_SKL) + ((size_t)b * TK_S + p) * 512 + 8 * lane) = w;
        if (lane < 32) *(unsigned*)(WSP(bf16_t, WS_SKP) + ((size_t)b * TK_S + p) * 64 + 2 * lane) = pk2(k1[q], k2[q]); }
}

__device__ __forceinline__ float log_alpha(const float (&wa)[16], float ba, const bf16_t* ag) {
    float a[8], b[8]; load8bf(ag, a); load8bf(ag + 8, b); float z = ba;
#pragma unroll
    for (int k = 0; k < 8; ++k) z = fmaf(a[k], wa[k], z);
#pragma unroll
    for (int k = 0; k < 8; ++k) z = fmaf(b[k], wa[8 + k], z);
    const float ls = fminf(z, 0.f) - log1pf(__expf(-fabsf(z)));
    return fmaxf(ls * (1.f / 16.f), -5.f);
}
__device__ __forceinline__ void p2_rows(const Ptrs& P, const WaveCtx& C) {
    const int lane = lane_now();
    bf16_t* H = WSP(bf16_t, WS_H);
    const int nx_ = (137 * 16 > C.ngw && 137 * 16 - C.ngw < C.ngw) ? 137 * 16 - C.ngw : 0;
    auto rows_a = [&]() __attribute__((always_inline)) {
    for (int row = C.gw - nx_; row < M_REAL; row += C.ngw - nx_) { if (row < 0) break;
        const int srow = row - R_SAMPLE; const bool is_s = (row >= R_SAMPLE && row < R_META);
        const int opos = row < R_SAMPLE ? row + N_META : (is_s ? srow : row - R_META);
        float c[8]; load8bf(H + (size_t)row * NH + HC_CKV + 8 * lane, c); float s = 0.f;
#pragma unroll
        for (int j = 0; j < 8; ++j) s += c[j] * c[j];
        const float rs = __builtin_amdgcn_rsqf(wave_sum(s) * (1.f / 512.f) + EPS);
        const f32x4 g0 = *(const f32x4*)(P.g_kv + 8 * lane), g1 = *(const f32x4*)(P.g_kv + 8 * lane + 4);
        float l[8];
#pragma unroll
        for (int j = 0; j < 8; ++j) l[j] = c[j] * rs * (j < 4 ? g0[j] : g1[j - 4]);
        float* lo = P.out + (is_s ? O_LATS : O_LATP) + (size_t)opos * 512 + 8 * lane;
        *(f32x4*)lo = (f32x4){l[0], l[1], l[2], l[3]}; *(f32x4*)(lo + 4) = (f32x4){l[4], l[5], l[6], l[7]};
        if (is_s) *(u32x4*)(WSP(bf16_t, WS_SKL) + ((size_t)(srow >> 4) * TK_S + PAST + (srow & 15)) * 512 + 8 * lane) = pack8(l);
        if (lane < 32) { const unsigned w = *(const unsigned*)(H + (size_t)row * NH + HC_KPE + 2 * lane); const float x1 = bflo(w), x2 = bfhi(w);
            const f32x2 cs = WSP(f32x2, WS_ROPE)[(size_t)row * 32 + lane]; const float o1 = x1 * cs.x - x2 * cs.y, o2 = x2 * cs.x + x1 * cs.y;
            float* ko = P.out + (is_s ? O_KRS : O_KRP) + (size_t)opos * 64; ko[lane] = o1; ko[lane + 32] = o2;
            const unsigned pw = pk2(o1, o2); *(unsigned*)(WSP(bf16_t, WS_KPE) + (size_t)row * 64 + 2 * lane) = pw;
            if (is_s) *(unsigned*)(WSP(bf16_t, WS_SKP) + ((size_t)(srow >> 4) * TK_S + PAST + (srow & 15)) * 64 + 2 * lane) = pw; }
    }
    };
    bool rows_done = false;
    LAS float* las = (LAS float*)(C.lds + C.wave * 16384);
    for (int it = C.gw; it < 137 * 16; it += C.ngw) { const int j = it >> 4, cb = it & 15, col = cb * 64 + lane, h = cb >> 2, dk = col & 255; const bool is_s = (j >= 128 && j < 136);
        float wa[16];
#pragma unroll
        for (int k = 0; k < 16; ++k) wa[k] = P.w_a2[k * 1024 + col];
        const float ba = P.b_a[col]; const int row0 = 64 * j;
        const u32x4 ag0 = *(const u32x4*)(H + (size_t)(row0 + lane) * NH + HC_AG), ag1 = *(const u32x4*)(H + (size_t)(row0 + lane) * NH + HC_AG + 8);
        const bf16_t* hcl = H + (size_t)row0 * NH + col;
        float qv[4][16], kv[4][16];
#define P2_LD(buf, sb) do { _Pragma("unroll") for (int rr = 0; rr < 16; ++rr) { const bf16_t* hp = hcl + (size_t)((sb) * 16 + rr) * NH; qv[buf][rr] = bf1(hp[HC_Q]); kv[buf][rr] = bf1(hp[HC_K]); } } while (0)
        P2_LD(0, 0); P2_LD(1, 1); P2_LD(2, 2); P2_LD(3, 3);
        if (!rows_done) { rows_a(); rows_done = true; }
        float bl[4];
#pragma unroll
        for (int sub = 0; sub < 4; ++sub) { float s = 0.f;
            for (int r = 16 * sub; r < 16 * sub + 16; ++r) {
                const unsigned a0 = __builtin_amdgcn_readlane(ag0.x, r), a1 = __builtin_amdgcn_readlane(ag0.y, r), a2 = __builtin_amdgcn_readlane(ag0.z, r), a3 = __builtin_amdgcn_readlane(ag0.w, r);
                const unsigned a4 = __builtin_amdgcn_readlane(ag1.x, r), a5 = __builtin_amdgcn_readlane(ag1.y, r), a6 = __builtin_amdgcn_readlane(ag1.z, r), a7 = __builtin_amdgcn_readlane(ag1.w, r);
                float z = ba;
                z = fmaf(bflo(a0), wa[0], z); z = fmaf(bfhi(a0), wa[1], z); z = fmaf(bflo(a1), wa[2], z); z = fmaf(bfhi(a1), wa[3], z); z = fmaf(bflo(a2), wa[4], z); z = fmaf(bfhi(a2), wa[5], z); z = fmaf(bflo(a3), wa[6], z); z = fmaf(bfhi(a3), wa[7], z);
                z = fmaf(bflo(a4), wa[8], z); z = fmaf(bfhi(a4), wa[9], z); z = fmaf(bflo(a5), wa[10], z); z = fmaf(bfhi(a5), wa[11], z); z = fmaf(bflo(a6), wa[12], z); z = fmaf(bfhi(a6), wa[13], z); z = fmaf(bflo(a7), wa[14], z); z = fmaf(bfhi(a7), wa[15], z);
                float la = fmaxf((fminf(z, 0.f) - __logf(1.f + __expf(-fabsf(z)))) * (1.f / 16.f), -5.f);
                if (row0 + r >= M_REAL) la = 0.f;
                las[r * 64 + lane] = la; s += la; }
            bl[sub] = s; }
        if (!is_s) { const float t = (bl[0] + bl[1]) + (bl[2] + bl[3]); bl[0] = bl[1] = bl[2] = bl[3] = t; WSP(float, WS_DECP)[j * 1024 + col] = __expf(t); }
        else {
#pragma unroll
            for (int sub = 0; sub < 4; ++sub) WSP(float, WS_DECS)[(4 * (j - 128) + sub) * 1024 + col] = __expf(bl[sub]); }
        float bc = 0.f; bf16_t* ket = WSP(bf16_t, WS_KET) + ((size_t)(j * 4 + h) * 256 + dk) * 64; bf16_t* hc = H + (size_t)row0 * NH + col;
        const int d5 = col & 31, pofs = (8 * ((d5 >> 2) & 3) + 4 * (d5 >> 4) + (d5 & 3)) - d5;
#pragma unroll
        for (int sub = 0; sub < 4; ++sub) { const float blast = bl[sub]; if (is_s) bc = 0.f;
#pragma unroll
            for (int r8 = 0; r8 < 2; ++r8) { float ke[8];
#pragma unroll
                for (int rr = 0; rr < 8; ++rr) { const int r = sub * 16 + r8 * 8 + rr; bf16_t* hp = hc + (size_t)r * NH; bc += las[r * 64 + lane]; const float q = qv[sub][r8 * 8 + rr], k = kv[sub][r8 * 8 + rr];
                    hp[HC_Q + pofs] = f2bf(q * __expf(bc) * (1.f / 16.f)); hp[HC_K + pofs] = f2bf(k * __expf(-bc)); ke[rr] = k * __expf(blast - bc); }
                *(u32x4*)(ket + (sub * 2 + r8) * 8) = pack8(ke); } }
#undef P2_LD
    }
    if (!rows_done) rows_a();
}

constexpr int MG_QP = 528, MG_VP = 1040, MG_AP = 144;
constexpr int MG_QD = 0, MG_KI = 64 * MG_QP, MG_V = 2 * 64 * MG_QP, MG_ATT = MG_V + 64 * MG_VP, MG_SSQ = MG_ATT + 64 * MG_AP, MG_END = MG_SSQ + 2048, MG_OT = 0;
static_assert(MG_END <= MISC_OFF && 64 * MG_VP <= MG_V, "merge LDS");
__device__ __forceinline__ void p4_unit(const Ptrs& P, LAS unsigned char* lds, const int wid, int j, int h) {
    const int lane = lane_now(), tid = wid * 64 + lane, l15 = lane & 15, g = lane >> 4;
    const bf16_t* H = WSP(bf16_t, WS_H); const int row0 = 64 * j; const bool is_s = (j >= 128 && j < 136);
    { const char* hb = (const char*)(H + (size_t)row0 * NH + h * 256); const unsigned oq = (unsigned)((tid >> 5) * NH + (tid & 31) * 8) * 2u;
      u32x4 a[4], k[4];
#pragma unroll
      for (int i = 0; i < 4; ++i) { a[i] = *(const u32x4*)(hb + HC_Q * 2 + (oq + (unsigned)i * (16u * NH * 2u))); k[i] = *(const u32x4*)(hb + HC_K * 2 + (oq + (unsigned)i * (16u * NH * 2u))); }
      const char* vb = (const char*)(H + (size_t)row0 * NH + HC_V + h * 512); const unsigned ov = (unsigned)((tid >> 6) * NH + (tid & 63) * 8) * 2u;
      u32x4 v[8];
#pragma unroll
      for (int i = 0; i < 8; ++i) v[i] = *(const u32x4*)(vb + (ov + (unsigned)i * (8u * NH * 2u)));
#pragma unroll
      for (int i = 0; i < 4; ++i) { const int idx = tid + i * 512, r = idx >> 5, c = idx & 31; *(LAS u32x4*)(lds + MG_QD + r * MG_QP + c * 16) = a[i]; *(LAS u32x4*)(lds + MG_KI + r * MG_QP + c * 16) = k[i]; }
#pragma unroll
      for (int i = 0; i < 8; ++i) { const int idx = tid + i * 512, r = idx >> 6, c = idx & 63; *(LAS u32x4*)(lds + MG_V + r * MG_VP + c * 16) = v[i]; } }
    u32x2 ogr[4][4];
    { const bf16_t* og = WSP(bf16_t, WS_OG) + (size_t)(row0 + l15) * DM + h * 512 + 64 * wid + 4 * g;
#pragma unroll
      for (int ct = 0; ct < 4; ++ct)
#pragma unroll
        for (int dt = 0; dt < 4; ++dt) ogr[ct][dt] = *(const u32x2*)(og + (size_t)(16 * ct) * DM + 16 * dt); }
    u32x4 pre[4][4];
    { const bf16_t* Qp = WSP(bf16_t, WS_Q);
#pragma unroll
      for (int i = 0; i < 4; ++i) { const int idx = tid + i * 512, r = idx >> 6, cc = (idx & 63) * 8; const bf16_t* hp = H + (size_t)(row0 + r) * NH + h * 512 + cc;
        pre[i][0] = *(const u32x4*)(hp + HC_R); pre[i][1] = *(const u32x4*)(hp + HC_GA); pre[i][2] = *(const u32x4*)(hp + HC_GB); pre[i][3] = *(const u32x4*)(Qp + (size_t)(row0 + r) * QP + h * 512 + cc); } }
    __syncthreads();
#pragma unroll
    for (int k2 = 0; k2 < 2; ++k2) { const int tt = 2 * wid + k2, st = tt >> 2, ct = tt & 3; f32x4 a = (f32x4){0.f, 0.f, 0.f, 0.f};
        if (is_s ? st == ct : st <= ct) {
#pragma unroll
            for (int ks = 0; ks < 8; ++ks) { const bf16x8 af = *(LAS const bf16x8*)(lds + MG_KI + (16 * st + l15) * MG_QP + (ks * 32 + 8 * g) * 2), bf = *(LAS const bf16x8*)(lds + MG_QD + (16 * ct + l15) * MG_QP + (ks * 32 + 8 * g) * 2);
                a = MFMA16(af, bf, a); }
            if (st == ct) {
#pragma unroll
                for (int r = 0; r < 4; ++r) if (4 * g + r > l15) a[r] = 0.f; } }
        u32x2 w; w.x = pk2(a[0], a[1]); w.y = pk2(a[2], a[3]); *(LAS u32x2*)(lds + MG_ATT + (16 * ct + l15) * MG_AP + (16 * st + 4 * g) * 2) = w; }
    __syncthreads();
    f32x4 o[4][4];
#pragma unroll
    for (int dt = 0; dt < 4; ++dt)
#pragma unroll
        for (int ct = 0; ct < 4; ++ct) o[dt][ct] = (f32x4){0.f, 0.f, 0.f, 0.f};
#pragma unroll
    for (int k2 = 0; k2 < 2; ++k2) { bf16x8 bf[4];
#pragma unroll
        for (int ct = 0; ct < 4; ++ct) bf[ct] = *(LAS const bf16x8*)(lds + MG_ATT + (16 * ct + l15) * MG_AP + (32 * k2 + 8 * g) * 2);
#pragma unroll
        for (int dt = 0; dt < 4; ++dt) { LAS const unsigned char* vp = lds + MG_V + (32 * k2 + 8 * g + (l15 >> 2)) * MG_VP + (64 * wid + 16 * dt + 4 * (l15 & 3)) * 2; const bf16x8 vf = cat8(lds_tr(vp), lds_tr(vp + 4 * MG_VP));
#pragma unroll
            for (int ct = 0; ct < 4; ++ct) { if (32 * k2 > 16 * ct + 15) continue; o[dt][ct] = MFMA16(vf, bf[ct], o[dt][ct]); } } }
    u32x4 pre2[2][4];
    { const bf16_t* Qp = WSP(bf16_t, WS_Q);
#pragma unroll
      for (int i = 0; i < 2; ++i) { const int idx = tid + (i + 4) * 512, r = idx >> 6, cc = (idx & 63) * 8; const bf16_t* hp = H + (size_t)(row0 + r) * NH + h * 512 + cc;
        pre2[i][0] = *(const u32x4*)(hp + HC_R); pre2[i][1] = *(const u32x4*)(hp + HC_GA); pre2[i][2] = *(const u32x4*)(hp + HC_GB); pre2[i][3] = *(const u32x4*)(Qp + (size_t)(row0 + r) * QP + h * 512 + cc); } }
    {
#pragma unroll
      for (int ct = 0; ct < 4; ++ct) { float sq = 0.f;
#pragma unroll
        for (int dt = 0; dt < 4; ++dt) { const u32x2 w = ogr[ct][dt]; o[dt][ct][0] += bflo(w.x); o[dt][ct][1] += bfhi(w.x); o[dt][ct][2] += bflo(w.y); o[dt][ct][3] += bfhi(w.y);
            sq += (o[dt][ct][0] * o[dt][ct][0] + o[dt][ct][1] * o[dt][ct][1]) + (o[dt][ct][2] * o[dt][ct][2] + o[dt][ct][3] * o[dt][ct][3]); }
        sq += __shfl_xor(sq, 16); sq += __shfl_xor(sq, 32);
        if (g == 0) *(LAS float*)(lds + MG_SSQ + ((16 * ct + l15) * 8 + wid) * 4) = sq; } }
    __syncthreads();
#pragma unroll
    for (int ct = 0; ct < 4; ++ct) { const f32x4 s0 = *(LAS const f32x4*)(lds + MG_SSQ + (16 * ct + l15) * 32), s1 = *(LAS const f32x4*)(lds + MG_SSQ + (16 * ct + l15) * 32 + 16);
        const float rs = __builtin_amdgcn_rsqf(((s0[0] + s0[1]) + (s0[2] + s0[3]) + (s1[0] + s1[1]) + (s1[2] + s1[3])) * (1.f / 512.f) + EPS);
#pragma unroll
        for (int dt = 0; dt < 4; ++dt) { u32x2 w; w.x = pk2(o[dt][ct][0] * rs, o[dt][ct][1] * rs); w.y = pk2(o[dt][ct][2] * rs, o[dt][ct][3] * rs);
            *(LAS u32x2*)(lds + MG_OT + (16 * ct + l15) * MG_VP + (64 * wid + 16 * dt + 4 * g) * 2) = w; } }
    __syncthreads();
    { const bf16_t* Q = WSP(bf16_t, WS_Q); bf16_t* MG = WSP(bf16_t, WS_MERGED);
#pragma unroll
      for (int i = 0; i < 8; ++i) { const int idx = tid + i * 512, r = idx >> 6, cc = (idx & 63) * 8; const bf16_t* hp = H + (size_t)(row0 + r) * NH + h * 512 + cc;
        float on[8], rr[8], ga[8], gb[8], om[8], ov[8];
        { const u32x4 w = *(LAS const u32x4*)(lds + MG_OT + r * MG_VP + cc * 2); on[0] = bflo(w.x); on[1] = bfhi(w.x); on[2] = bflo(w.y); on[3] = bfhi(w.y); on[4] = bflo(w.z); on[5] = bfhi(w.z); on[6] = bflo(w.w); on[7] = bfhi(w.w); }
        if (i < 4) { unpack8bf(pre[i & 3][0], rr); unpack8bf(pre[i & 3][1], ga); unpack8bf(pre[i & 3][2], gb); unpack8bf(pre[i & 3][3], om); }
        else if (i < 6) { unpack8bf(pre2[i & 1][0], rr); unpack8bf(pre2[i & 1][1], ga); unpack8bf(pre2[i & 1][2], gb); unpack8bf(pre2[i & 1][3], om); }
        else { load8bf(hp + HC_R, rr); load8bf(hp + HC_GA, ga); load8bf(hp + HC_GB, gb); load8bf(Q + (size_t)(row0 + r) * QP + h * 512 + cc, om); }
        const f32x4 g0 = *(const f32x4*)(P.g_gla + cc), g1 = *(const f32x4*)(P.g_gla + cc + 4);
#pragma unroll
        for (int q = 0; q < 8; ++q) ov[q] = sigmoidf_(ga[q]) * (on[q] * (q < 4 ? g0[q] : g1[q - 4])) * (rr[q] * sigmoidf_(rr[q])) + sigmoidf_(gb[q]) * om[q];
        *(u32x4*)(MG + (size_t)(row0 + r) * DM + h * 512 + cc) = pack8(ov); } }
    __syncthreads();
}

constexpr int I_UP = 32 * 176, I_DN = 88 * 32, I_FFN = I_UP + I_DN;
__device__ __forceinline__ void ffn_wconv_item(const Ptrs& P, LAS unsigned char* scr, int it, int lane) {
    if (it < I_UP) transpose_item(P.w_up, DM, DFF2, P.g_ffn, WSP(bf16_t, WS_WUPT), scr, it, 176, lane, MapId());
    else transpose_item(P.w_down, DFF, DM, nullptr, WSP(bf16_t, WS_WDT), scr, it - I_UP, 32, lane, MapId());
}

constexpr int I_SKU = DFF2 / 64;
__device__ __forceinline__ void skinny_up_item(const Ptrs& P, int item, int lane) {
    const int l15 = lane & 15, g = lane >> 4, n0 = 64 * item;
    const bf16_t* ap = WSP(bf16_t, WS_X2B) + (size_t)(R_META + l15) * DM + 8 * g; const bf16_t* bp = WSP(bf16_t, WS_WUPT) + (size_t)(n0 + l15) * DM + 8 * g;
    f32x4 acc[4]; for (int t = 0; t < 4; ++t) acc[t] = (f32x4){0.f, 0.f, 0.f, 0.f};
#pragma unroll 4
    for (int ks = 0; ks < DM / 32; ++ks) { const bf16x8 a = *(const bf16x8*)(ap + 32 * ks);
#pragma unroll
        for (int t = 0; t < 4; ++t) acc[t] = MFMA16(a, *(const bf16x8*)(bp + (size_t)(16 * t) * DM + 32 * ks), acc[t]); }
    bf16_t* U = WSP(bf16_t, WS_H);
#pragma unroll
    for (int t = 0; t < 4; ++t)
#pragma unroll
        for (int r = 0; r < 4; ++r) U[(size_t)(R_META + 4 * g + r) * DFF2 + n0 + 16 * t + l15] = f2bf(acc[t][r]);
}

__device__ __forceinline__ float rs2_of(const float* ss2, int row, int lane) { float v = lane < 32 ? ss2[row * 32 + lane] : 0.f; return __builtin_amdgcn_rsqf(wave_sum(v) * (1.f / DM) + EPS); }
__device__ __forceinline__ void ld8f(const float* p, float (&v)[8]) { const f32x4 a = *(const f32x4*)p, b = *(const f32x4*)(p + 4); v[0] = a[0]; v[1] = a[1]; v[2] = a[2]; v[3] = a[3]; v[4] = b[0]; v[5] = b[1]; v[6] = b[2]; v[7] = b[3]; }
__device__ __forceinline__ void p7_conv(const Ptrs& P, const WaveCtx& C) {
    const int lane = lane_now(), tid = C.wave * 64 + lane;
    const bf16_t* __restrict__ U = WSP(bf16_t, WS_H); bf16_t* __restrict__ GT = WSP(bf16_t, WS_GATE); const float* ss2 = WSP(float, WS_SS2);
    constexpr int NPI = (T_P + 4) / 5;
    for (int ibase = 0; ibase < NPI + 128; ibase += C.ngw) {
    const int item = ibase + C.gw; int row0, nr; bool have = true;
    if (item < NPI) { row0 = 5 * item; nr = min(5, T_P - row0); } else if (item < NPI + 128) { row0 = R_SAMPLE + 4 * (item - NPI); nr = 4; } else { have = false; row0 = 0; nr = 0; }
    int pa = 0, pb = 0; const float *ha = nullptr, *hb = nullptr; float rs[7] = {1.f, 1.f, 1.f, 1.f, 1.f, 1.f, 1.f};
    if (have) {
        if (row0 < R_SAMPLE) { pa = row0 >= 2 ? row0 - 2 : R_META + 14; pb = row0 >= 1 ? row0 - 1 : R_META + 15; }
        else { const int sr = row0 - R_SAMPLE, b = sr >> 4, t = sr & 15; pa = row0 - 2; pb = row0 - 1; if (t == 0) { ha = P.cache_conv + (size_t)b * 2 * DFF2; hb = ha + DFF2; pa = pb = -1; } }
        if (pa >= 0) { rs[0] = rs2_of(ss2, pa, lane); rs[1] = rs2_of(ss2, pb, lane); }
#pragma unroll
        for (int r = 0; r < 5; ++r) if (r < nr) rs[2 + r] = rs2_of(ss2, row0 + r, lane); }
    LAS unsigned char* slot = C.lds + 16384 + C.wave * 14336;
#define P7_DMA(it_) do { if (have) { _Pragma("unroll") for (int hf = 0; hf < 2; ++hf) { const bf16_t* ub_ = U + hf * DFF + (it_) * 512 + lane * 8; \
        if (pa >= 0) { __builtin_amdgcn_global_load_lds((const unsigned*)(ub_ + (size_t)pa * DFF2), (LAS unsigned*)(slot + (hf * 7 + 0) * 1024), 16, 0, 0); \
                       __builtin_amdgcn_global_load_lds((const unsigned*)(ub_ + (size_t)pb * DFF2), (LAS unsigned*)(slot + (hf * 7 + 1) * 1024), 16, 0, 0); } \
        _Pragma("unroll") for (int r = 0; r < 5; ++r) if (r < nr) __builtin_amdgcn_global_load_lds((const unsigned*)(ub_ + (size_t)(row0 + r) * DFF2), (LAS unsigned*)(slot + (hf * 7 + 2 + r) * 1024), 16, 0, 0); } } } while (0)
#define P7_WDMA(it_) do { _Pragma("unroll") for (int q = 0; q < 2; ++q) { const int idx = tid + q * 512, arr = idx >> 7, c4 = (idx & 127) * 4, hf = arr >> 2, tp = arr & 3; \
        const float* src = (tp < 3 ? P.conv_w + (size_t)tp * DFF2 : P.conv_b) + hf * DFF + (it_) * 512 + c4; \
        __builtin_amdgcn_global_load_lds((const unsigned*)src, (LAS unsigned*)(C.lds + (((it_) & 1) ? 131072 : 0) + (C.wave * 64 + q * 512) * 16), 16, 0, 0); } } while (0)
    P7_DMA(0); P7_WDMA(0);
    auto p7_block = [&](const int it, const int wofs_) __attribute__((always_inline)) { const int n = (it * 64 + lane) * 8;
        LAS const float* wl = (LAS const float*)(C.lds + wofs_);
        u32x4 ub[2][7];
        asm volatile("s_waitcnt vmcnt(0)" ::: "memory");
        __syncthreads();
        if (it + 1 < 11) P7_WDMA(it + 1);
        if (have) {
#pragma unroll
            for (int hf = 0; hf < 2; ++hf) { const int nn = n + hf * DFF;
                if (pa >= 0) { ub[hf][0] = *(LAS const u32x4*)(slot + (hf * 7 + 0) * 1024 + lane * 16); ub[hf][1] = *(LAS const u32x4*)(slot + (hf * 7 + 1) * 1024 + lane * 16); }
                else { float t0[8], t1[8]; ld8f(ha + nn, t0); ld8f(hb + nn, t1); ub[hf][0] = pack8(t0); ub[hf][1] = pack8(t1); }
#pragma unroll
                for (int r = 0; r < 5; ++r) if (r < nr) ub[hf][2 + r] = *(LAS const u32x4*)(slot + (hf * 7 + 2 + r) * 1024 + lane * 16); } }
        asm volatile("s_waitcnt lgkmcnt(0)" ::: "memory");
        if (it + 1 < 11) P7_DMA(it + 1);
        if (have) { float c0[5][8];
#pragma unroll
            for (int hf = 0; hf < 2; ++hf) { float u[7][8], w[4][8];
#pragma unroll
                for (int r = 0; r < 7; ++r) { if (r >= 2 && r - 2 >= nr) continue; const u32x4 x = ub[hf][r];
                    u[r][0] = bflo(x.x) * rs[r]; u[r][1] = bfhi(x.x) * rs[r]; u[r][2] = bflo(x.y) * rs[r]; u[r][3] = bfhi(x.y) * rs[r]; u[r][4] = bflo(x.z) * rs[r]; u[r][5] = bfhi(x.z) * rs[r]; u[r][6] = bflo(x.w) * rs[r]; u[r][7] = bfhi(x.w) * rs[r]; }
#pragma unroll
                for (int tp = 0; tp < 4; ++tp) { const f32x4 a = *(LAS const f32x4*)(wl + (hf * 4 + tp) * 512 + lane * 8), b = *(LAS const f32x4*)(wl + (hf * 4 + tp) * 512 + lane * 8 + 4);
                    w[tp][0] = a[0]; w[tp][1] = a[1]; w[tp][2] = a[2]; w[tp][3] = a[3]; w[tp][4] = b[0]; w[tp][5] = b[1]; w[tp][6] = b[2]; w[tp][7] = b[3]; }
#pragma unroll
                for (int r = 0; r < 5; ++r) { if (r >= nr) continue; const int row = row0 + r;
                    float* cvo = nullptr;
                    if (row >= T_P - 2 && row < T_P) cvo = P.out + O_CVP + (size_t)(row - (T_P - 2)) * DFF2;
                    else if (row >= R_SAMPLE && ((row - R_SAMPLE) & 15) >= 14) cvo = P.out + O_CVS + (size_t)(((row - R_SAMPLE) >> 4) * 2 + (((row - R_SAMPLE) & 15) - 14)) * DFF2;
                    if (cvo) { float* o = cvo + n + hf * DFF; *(f32x4*)o = (f32x4){u[r + 2][0], u[r + 2][1], u[r + 2][2], u[r + 2][3]}; *(f32x4*)(o + 4) = (f32x4){u[r + 2][4], u[r + 2][5], u[r + 2][6], u[r + 2][7]}; }
#pragma unroll
                    for (int q = 0; q < 8; ++q) { const float c = w[3][q] + w[0][q] * u[r][q] + w[1][q] * u[r + 1][q] + w[2][q] * u[r + 2][q];
                        if (hf == 0) c0[r][q] = c; else c0[r][q] = c0[r][q] * sigmoidf_(c0[r][q]) * c; }
                    if (hf == 1) *(u32x4*)(GT + (size_t)row * DFF + n) = pack8(c0[r]); } }
        }
    };
#pragma unroll 1
    for (int it = 0; it < 11; it += 2) { p7_block(it, 0); if (it + 1 < 11) p7_block(it + 1, 131072); }
    }
#undef P7_DMA
#undef P7_WDMA
}


__device__ __forceinline__ void p9_final(const Ptrs& P, const WaveCtx& C) {
    const int lane = lane_now();
    for (int row = C.gw; row < R_META; row += 2 * C.ngw) { const int rowb = row + C.ngw; const bool hb = rowb < R_META;
        float* xa = P.out + (size_t)row * DM; float* xb = P.out + (size_t)(hb ? rowb : row) * DM; f32x4 va[8], vb[8]; float sa = 0.f, sb = 0.f;
#pragma unroll
        for (int j = 0; j < 8; ++j) { va[j] = *(const f32x4*)(xa + (j * 64 + lane) * 4); vb[j] = *(const f32x4*)(xb + (j * 64 + lane) * 4); }
#pragma unroll
        for (int j = 0; j < 8; ++j) { sa += (va[j][0] * va[j][0] + va[j][1] * va[j][1]) + (va[j][2] * va[j][2] + va[j][3] * va[j][3]); sb += (vb[j][0] * vb[j][0] + vb[j][1] * vb[j][1]) + (vb[j][2] * vb[j][2] + vb[j][3] * vb[j][3]); }
        const float ra = __builtin_amdgcn_rsqf(wave_sum(sa) * (1.f / DM) + EPS), rb = __builtin_amdgcn_rsqf(wave_sum(sb) * (1.f / DM) + EPS);
#pragma unroll
        for (int j = 0; j < 8; ++j) { const f32x4 g = *(const f32x4*)(P.final_norm + (j * 64 + lane) * 4); *(f32x4*)(xa + (j * 64 + lane) * 4) = va[j] * ra * g; if (hb) *(f32x4*)(xb + (j * 64 + lane) * 4) = vb[j] * rb * g; }
    }
}
__device__ __forceinline__ int crow(int r, int hi) { return (r & 3) + 8 * (r >> 2) + 4 * hi; }
__device__ __forceinline__ float hswap_max(float v) { auto rr = __builtin_amdgcn_permlane32_swap(__float_as_uint(v), __float_as_uint(v), false, false); return fmaxf(__uint_as_float(rr[0]), __uint_as_float(rr[1])); }
__device__ __forceinline__ float hswap_sum(float v) { auto rr = __builtin_amdgcn_permlane32_swap(__float_as_uint(v), __float_as_uint(v), false, false); return __uint_as_float(rr[0]) + __uint_as_float(rr[1]); }

constexpr int AT_KN = 16384, AT_KP = 8192, AT_V = 16384, AT_BUF = AT_KN + AT_KP + AT_V;
static_assert(3 * AT_BUF <= MISC_OFF, "attention LDS");
__device__ __forceinline__ void attn_prompt_unit(const Ptrs& P, LAS unsigned char* lds, const int wid, int h, int qrow0, int nprompt, int tlim0) {
    const int lane = lane_now(), r32 = lane & 31, hi = lane >> 5;
    bf16_t* Q = WSP(bf16_t, WS_Q); const bf16_t* KV = WSP(bf16_t, WS_KV); const bf16_t* KPE = WSP(bf16_t, WS_KPE);
    const int NT = nprompt + 1, tlim = tlim0 + (wid >> 1);
    bf16x8 qn[8], qp[4];
    { const bf16_t* qrow = Q + (size_t)(qrow0 + wid * 32 + r32) * QP;
#pragma unroll
      for (int ks = 0; ks < 8; ++ks) qn[ks] = *(const bf16x8*)(qrow + h * 128 + ks * 16 + hi * 8);
#pragma unroll
      for (int ks = 0; ks < 4; ++ks) qp[ks] = *(const bf16x8*)(qrow + 2048 + h * 64 + ks * 16 + hi * 8); }
    const int l4 = lane >> 4, c16 = lane & 15;
    const unsigned okn0 = (unsigned)((8 * wid + l4) * 4096 + (c16 ^ ((8 * wid + l4) & 15)) * 8) * 2u, okn1 = (unsigned)((8 * wid + 4 + l4) * 4096 + (c16 ^ ((8 * wid + 4 + l4) & 15)) * 8) * 2u;
    const unsigned ov0 = (unsigned)((8 * wid + l4) * 4096 + 2048 + (c16 ^ ((l4 & 3) << 2)) * 8) * 2u;
    const unsigned okp = (unsigned)((8 * wid + (lane >> 3)) * 64 + ((lane & 7) ^ (((8 * wid + (lane >> 3)) >> 1) & 7)) * 8) * 2u;
#define AT_DMA(t, bo_) do { const int kvr = (t) == 0 ? 32 * 256 : ((t) - 1) * 64; const int kpr = (t) == 0 ? R_META : ((t) - 1) * 64; \
        const char* kb_ = (const char*)(KV + (size_t)kvr * 4096 + h * 128); const char* pb_ = (const char*)(KPE + (size_t)kpr * 64); \
        __builtin_amdgcn_global_load_lds((const unsigned*)(kb_ + okn0), (LAS unsigned*)(lds + (bo_) + (2 * wid) * 1024), 16, 0, 0); \
        __builtin_amdgcn_global_load_lds((const unsigned*)(kb_ + okn1), (LAS unsigned*)(lds + (bo_) + (2 * wid + 1) * 1024), 16, 0, 0); \
        __builtin_amdgcn_global_load_lds((const unsigned*)(pb_ + okp), (LAS unsigned*)(lds + (bo_) + AT_KN + wid * 1024), 16, 0, 0); \
        __builtin_amdgcn_global_load_lds((const unsigned*)(kb_ + ov0), (LAS unsigned*)(lds + (bo_) + AT_KN + AT_KP + (2 * wid) * 1024), 16, 0, 0); \
        __builtin_amdgcn_global_load_lds((const unsigned*)(kb_ + ov0 + 4u * 4096u * 2u), (LAS unsigned*)(lds + (bo_) + AT_KN + AT_KP + (2 * wid + 1) * 1024), 16, 0, 0); } while (0)
    f32x16 o[4]; for (int d = 0; d < 4; ++d) o[d] = (f32x16){0.f, 0.f, 0.f, 0.f, 0.f, 0.f, 0.f, 0.f, 0.f, 0.f, 0.f, 0.f, 0.f, 0.f, 0.f, 0.f};
    float m_run = -1e30f, l_run = 0.f;
    const int vq_ = (lane & 15) >> 2, vin_ = (4 * hi + vq_) * 256 + 32 * ((lane >> 4) & 1) + 8 * (lane & 3);
    const int vb0 = vin_ + ((0 ^ vq_) << 6), vb1 = vin_ + ((1 ^ vq_) << 6), vb2 = vin_ + ((2 ^ vq_) << 6), vb3 = vin_ + ((3 ^ vq_) << 6);
    AT_DMA(0, 0);
    if (NT > 1) AT_DMA(1, AT_BUF);
    asm volatile("" :: "v"(qn[0]), "v"(qn[1]), "v"(qn[2]), "v"(qn[3]), "v"(qn[4]), "v"(qn[5]), "v"(qn[6]), "v"(qn[7]), "v"(qp[0]), "v"(qp[1]), "v"(qp[2]), "v"(qp[3]));
#define AT_PVD 4
#define AT_VRD(lo_, hh_, m_) do { const unsigned va_ = vbo_ + (unsigned)(((m_) & 3) == 0 ? vb0 : ((m_) & 3) == 1 ? vb1 : ((m_) & 3) == 2 ? vb2 : vb3); \
        asm volatile("ds_read_b64_tr_b16 %0, %1 offset:%2" : "=v"(lo_) : "v"(va_), "n"((16 * ((m_) >> 2)) * 256)); \
        asm volatile("ds_read_b64_tr_b16 %0, %1 offset:%2" : "=v"(hh_) : "v"(va_), "n"((16 * ((m_) >> 2) + 8) * 256)); } while (0)
#define AT_PV(bo_) do { const unsigned vbo_ = (unsigned)(size_t)(lds + (bo_) + AT_KN + AT_KP); s16x4 vl_[AT_PVD], vh_[AT_PVD]; __builtin_amdgcn_s_setprio(1); \
        _Pragma("unroll") for (int m = 0; m < AT_PVD; ++m) AT_VRD(vl_[m], vh_[m], m); \
        _Pragma("unroll") for (int m = 0; m < 16; ++m) { \
            if (m <= 16 - AT_PVD) asm volatile("s_waitcnt lgkmcnt(6)" : "+v"(vl_[m % AT_PVD]), "+v"(vh_[m % AT_PVD])); else if (m == 13) asm volatile("s_waitcnt lgkmcnt(4)" : "+v"(vl_[m % AT_PVD]), "+v"(vh_[m % AT_PVD])); \
            else if (m == 14) asm volatile("s_waitcnt lgkmcnt(2)" : "+v"(vl_[m % AT_PVD]), "+v"(vh_[m % AT_PVD])); else asm volatile("s_waitcnt lgkmcnt(0)" : "+v"(vl_[m % AT_PVD]), "+v"(vh_[m % AT_PVD])); \
            const bf16x8 pf_ = (m >> 2) == 0 ? pf0 : (m >> 2) == 1 ? pf1 : (m >> 2) == 2 ? pf2 : pf3; \
            o[m & 3] = MFMA32(cat8(vl_[m % AT_PVD], vh_[m % AT_PVD]), pf_, o[m & 3]); \
            if (m + AT_PVD < 16) AT_VRD(vl_[m % AT_PVD], vh_[m % AT_PVD], m + AT_PVD); } \
        __builtin_amdgcn_s_setprio(0); } while (0)
#define AT_PACK(P, B) __builtin_bit_cast(bf16x8, (u32x4){pk2(P[B + 0], P[B + 1]), pk2(P[B + 2], P[B + 3]), pk2(P[B + 4], P[B + 5]), pk2(P[B + 6], P[B + 7])})
    int bo = 0, bo2 = 2 * AT_BUF;
    for (int t = 0; t < NT; ++t) {
        if (t + 1 < NT) asm volatile("s_waitcnt vmcnt(5)" ::: "memory"); else asm volatile("s_waitcnt vmcnt(0)" ::: "memory");
        __syncthreads();
        if (t + 2 < NT) AT_DMA(t + 2, bo2);
        const bool act = (t == 0 || (t - 1) <= tlim);
        if (act) {
            LAS const unsigned char* bb = lds + bo;
            f32x16 p[2];
            p[0] = (f32x16){0.f, 0.f, 0.f, 0.f, 0.f, 0.f, 0.f, 0.f, 0.f, 0.f, 0.f, 0.f, 0.f, 0.f, 0.f, 0.f}; p[1] = p[0];
            { const unsigned c0 = (unsigned)((hi * 16) ^ ((r32 & 15) << 4)), c0p = (unsigned)((hi * 16) ^ (((r32 >> 1) & 7) << 4));
              const unsigned rbn = (unsigned)(size_t)(bb + r32 * 256), rbp = (unsigned)(size_t)(bb + AT_KN + r32 * 128);
#define AT_KRDA(dst, i) do { if (((i) >> 1) < 8) { const unsigned a_ = rbn + ((unsigned)(((i) >> 1) * 32) ^ c0); asm volatile("ds_read_b128 %0, %1 offset:%2" : "=v"(dst) : "v"(a_), "n"(((i) & 1) * 8192)); } \
                  else { const unsigned a_ = rbp + ((unsigned)((((i) >> 1) - 8) * 32) ^ c0p); asm volatile("ds_read_b128 %0, %1 offset:%2" : "=v"(dst) : "v"(a_), "n"(((i) & 1) * 4096)); } } while (0)
#define AT_KW(n_, r_) asm volatile("s_waitcnt lgkmcnt(" #n_ ")" : "+v"(r_))
              bf16x8 kr[12];
#pragma unroll
              for (int i = 0; i < 12; ++i) AT_KRDA(kr[i], i);
              __builtin_amdgcn_s_setprio(1);
#pragma unroll
              for (int i = 0; i < 24; ++i) { const int ks = i >> 1; const bf16x8 qf = ks < 8 ? qn[ks < 8 ? ks : 0] : qp[ks < 8 ? 0 : ks - 8];
                  if (i <= 12) AT_KW(11, kr[i % 12]); else if (i == 13) AT_KW(10, kr[i % 12]); else if (i == 14) AT_KW(9, kr[i % 12]); else if (i == 15) AT_KW(8, kr[i % 12]); else if (i == 16) AT_KW(7, kr[i % 12]);
                  else if (i == 17) AT_KW(6, kr[i % 12]); else if (i == 18) AT_KW(5, kr[i % 12]); else if (i == 19) AT_KW(4, kr[i % 12]); else if (i == 20) AT_KW(3, kr[i % 12]); else if (i == 21) AT_KW(2, kr[i % 12]);
                  else if (i == 22) AT_KW(1, kr[i % 12]); else AT_KW(0, kr[i % 12]);
                  p[i & 1] = MFMA32(kr[i % 12], qf, p[i & 1]);
                  if (i + 12 < 24) AT_KRDA(kr[i % 12], i + 12); }
              __builtin_amdgcn_s_setprio(0);
#undef AT_KRDA
#undef AT_KW
            }
            if (t == 0) {
#pragma unroll
                for (int r = 0; r < 16; ++r) { if (crow(r, hi) >= N_META) p[0][r] = -INFINITY; p[1][r] = -INFINITY; } }
            float mx = p[0][0];
#pragma unroll
            for (int r = 1; r < 16; ++r) mx = fmaxf(mx, p[0][r]);
#pragma unroll
            for (int r = 0; r < 16; ++r) mx = fmaxf(mx, p[1][r]);
            mx = hswap_max(mx);
            if (!__all(mx - m_run <= 8.f)) { const float m_new = fmaxf(m_run, mx), alpha = __builtin_amdgcn_exp2f(m_run - m_new); m_run = m_new; l_run *= alpha;
#pragma unroll
                for (int d = 0; d < 4; ++d)
#pragma unroll
                    for (int r = 0; r < 16; ++r) o[d][r] *= alpha; }
            float ps = 0.f;
#pragma unroll
            for (int kb = 0; kb < 2; ++kb)
#pragma unroll
                for (int r = 0; r < 16; ++r) { p[kb][r] = __builtin_amdgcn_exp2f(p[kb][r] - m_run); ps += p[kb][r]; }
            l_run += ps;
            const bf16x8 pf0 = AT_PACK(p[0], 0), pf1 = AT_PACK(p[0], 8), pf2 = AT_PACK(p[1], 0), pf3 = AT_PACK(p[1], 8);
            AT_PV(bo);
        }
        { const int nb = bo + AT_BUF, nb2 = bo2 + AT_BUF; bo = nb >= 3 * AT_BUF ? 0 : nb; bo2 = nb2 >= 3 * AT_BUF ? 0 : nb2; }
    }
    __syncthreads();
#undef AT_PV
#undef AT_VRD
#undef AT_PACK
#undef AT_DMA
    const float inv = 1.f / hswap_sum(l_run);
    bf16_t* orow = Q + (size_t)(qrow0 + wid * 32 + r32) * QP + h * 128;
#pragma unroll
    for (int d = 0; d < 4; ++d)
#pragma unroll
        for (int g = 0; g < 4; ++g) { u32x2 w; w.x = pk2(o[d][4 * g] * inv, o[d][4 * g + 1] * inv); w.y = pk2(o[d][4 * g + 2] * inv, o[d][4 * g + 3] * inv);
            *(u32x2*)(orow + 32 * d + 8 * g + 4 * hi) = w; }
}

constexpr int SA_P = 1040, SA_RP = 32 * SA_P, SA_BUF = SA_RP + 32 * 128;
static_assert(3 * SA_BUF <= RING_BYTES, "sample attention LDS");
__device__ __forceinline__ void attn_sample_unit(const Ptrs& P, LAS unsigned char* lds, const int wid, int b, int hq) {
    const int lane = lane_now(), l15 = lane & 15, g = lane >> 4;
    const int head = hq * 4 + (wid & 3), dvh = wid >> 2;
    bf16_t* Q = WSP(bf16_t, WS_Q); const bf16_t* QL = WSP(bf16_t, WS_QLAT); const bf16_t* SKL = WSP(bf16_t, WS_SKL) + (size_t)b * TK_S * 512; const bf16_t* SKP = WSP(bf16_t, WS_SKP) + (size_t)b * TK_S * 64;
    bf16x8 qf[18];
    { const bf16_t* ql = QL + (size_t)(b * 16 + l15) * 8192 + head * 512 + 8 * g; const bf16_t* qpe = Q + (size_t)(R_SAMPLE + b * 16 + l15) * QP + 2048 + head * 64 + 8 * g;
#pragma unroll
      for (int ks = 0; ks < 16; ++ks) qf[ks] = *(const bf16x8*)(ql + ks * 32);
      qf[16] = *(const bf16x8*)qpe; qf[17] = *(const bf16x8*)(qpe + 32); }
    constexpr int NT = 33;
#define SA_DMA(t, bo) do { const int k0_ = (t) * 32 + 4 * wid; \
        _Pragma("unroll") for (int i = 0; i < 4; ++i) { const int key = min(k0_ + i, TK_S - 1); \
            __builtin_amdgcn_global_load_lds((const unsigned*)(SKL + (size_t)key * 512 + lane * 8), (LAS unsigned*)(lds + (bo) + (4 * wid + i) * SA_P), 16, 0, 0); } \
        if (lane < 32) { const int r = 4 * wid + (lane >> 3), key = min((t) * 32 + r, TK_S - 1); \
            __builtin_amdgcn_global_load_lds((const unsigned*)(SKP + (size_t)key * 64 + (((lane & 7) ^ ((r >> 1) & 7)) * 8)), (LAS unsigned*)(lds + (bo) + SA_RP + 4 * wid * 128), 16, 0, 0); } } while (0)
    f32x4 o[16]; for (int d = 0; d < 16; ++d) o[d] = (f32x4){0.f, 0.f, 0.f, 0.f};
    float m_run = -1e30f, l_run = 0.f;
    const int trb = (4 * g + (l15 >> 2)) * SA_P + (dvh * 256 + 4 * (l15 & 3)) * 2;
    const int rsw = (l15 >> 1) & 7;
    SA_DMA(0, 0); SA_DMA(1, SA_BUF);
    int bo = 0, bo2 = 2 * SA_BUF;
    for (int t = 0; t < NT; ++t) {
        if (t + 1 < NT) asm volatile("s_waitcnt vmcnt(5)" ::: "memory"); else asm volatile("s_waitcnt vmcnt(0)" ::: "memory");
        __syncthreads();
        if (t + 2 < NT) SA_DMA(t + 2, bo2);
        LAS const unsigned char* bb = lds + bo;
        f32x4 p[2]; p[0] = (f32x4){0.f, 0.f, 0.f, 0.f}; p[1] = p[0];
        { const unsigned kla = (unsigned)(size_t)(bb + l15 * SA_P + g * 16), kra0 = (unsigned)(size_t)(bb + SA_RP + l15 * 128 + ((g ^ rsw) * 16)), kra1 = (unsigned)(size_t)(bb + SA_RP + l15 * 128 + (((4 + g) ^ rsw) * 16));
#define SA_KRD(dst, i) do { if (((i) >> 1) < 16) asm volatile("ds_read_b128 %0, %1 offset:%2" : "=v"(dst) : "v"(kla), "n"(((i) & 1) * 16 * SA_P + ((i) >> 1) * 64)); \
            else if (((i) >> 1) == 16) asm volatile("ds_read_b128 %0, %1 offset:%2" : "=v"(dst) : "v"(kra0), "n"(((i) & 1) * 2048)); \
            else asm volatile("ds_read_b128 %0, %1 offset:%2" : "=v"(dst) : "v"(kra1), "n"(((i) & 1) * 2048)); } while (0)
          bf16x8 kr[6];
#pragma unroll
          for (int i = 0; i < 6; ++i) SA_KRD(kr[i], i);
#pragma unroll
          for (int i = 0; i < 36; ++i) {
              if (i <= 30) asm volatile("s_waitcnt lgkmcnt(5)" : "+v"(kr[i % 6])); else if (i == 31) asm volatile("s_waitcnt lgkmcnt(4)" : "+v"(kr[i % 6])); else if (i == 32) asm volatile("s_waitcnt lgkmcnt(3)" : "+v"(kr[i % 6]));
              else if (i == 33) asm volatile("s_waitcnt lgkmcnt(2)" : "+v"(kr[i % 6])); else if (i == 34) asm volatile("s_waitcnt lgkmcnt(1)" : "+v"(kr[i % 6])); else asm volatile("s_waitcnt lgkmcnt(0)" : "+v"(kr[i % 6]));
              p[i & 1] = MFMA16(kr[i % 6], qf[i >> 1], p[i & 1]);
              if (i + 6 < 36) SA_KRD(kr[i % 6], i + 6); }
#undef SA_KRD
        }
        if (t == NT - 1) {
#pragma unroll
            for (int blk = 0; blk < 2; ++blk)
#pragma unroll
                for (int r = 0; r < 4; ++r) if (t * 32 + 16 * blk + 4 * g + r >= TK_S) p[blk][r] = -INFINITY; }
        float mx = fmaxf(fmaxf(fmaxf(p[0][0], p[0][1]), fmaxf(p[0][2], p[0][3])), fmaxf(fmaxf(p[1][0], p[1][1]), fmaxf(p[1][2], p[1][3])));
        mx = fmaxf(mx, __shfl_xor(mx, 16)); mx = fmaxf(mx, __shfl_xor(mx, 32));
        const float m_new = fmaxf(m_run, mx), alpha = __builtin_amdgcn_exp2f(m_run - m_new); m_run = m_new;
        float ps = 0.f;
#pragma unroll
        for (int blk = 0; blk < 2; ++blk)
#pragma unroll
            for (int r = 0; r < 4; ++r) { p[blk][r] = __builtin_amdgcn_exp2f(p[blk][r] - m_new); ps += p[blk][r]; }
        l_run = l_run * alpha + ps;
        u32x4 pw; pw.x = pk2(p[0][0], p[0][1]); pw.y = pk2(p[0][2], p[0][3]); pw.z = pk2(p[1][0], p[1][1]); pw.w = pk2(p[1][2], p[1][3]);
        const bf16x8 pf = __builtin_bit_cast(bf16x8, pw);
        { const unsigned va = (unsigned)(size_t)(bb + trb);
          s16x4 va0[8], va1[8];
#define SA_TRG(dst, g4) do { _Pragma("unroll") for (int dd = 0; dd < 4; ++dd) { \
              asm volatile("ds_read_b64_tr_b16 %0, %1 offset:%2" : "=v"(dst[2 * dd]) : "v"(va), "n"(((g4) * 4 + dd) * 32)); \
              asm volatile("ds_read_b64_tr_b16 %0, %1 offset:%2" : "=v"(dst[2 * dd + 1]) : "v"(va), "n"(16 * SA_P + ((g4) * 4 + dd) * 32)); } } while (0)
#define SA_TRW(dst, n) asm volatile("s_waitcnt lgkmcnt(" #n ")" : "+v"(dst[0]), "+v"(dst[1]), "+v"(dst[2]), "+v"(dst[3]), "+v"(dst[4]), "+v"(dst[5]), "+v"(dst[6]), "+v"(dst[7]))
#define SA_PVG(src, g4) do { _Pragma("unroll") for (int dd = 0; dd < 4; ++dd) { const int d = (g4) * 4 + dd; o[d] = MFMA16(cat8(src[2 * dd], src[2 * dd + 1]), pf, o[d]); } } while (0)
#pragma unroll
          for (int d = 0; d < 16; ++d) o[d] *= alpha;
          SA_TRG(va0, 0); SA_TRG(va1, 1); SA_TRW(va0, 8); SA_PVG(va0, 0);
          SA_TRG(va0, 2); SA_TRW(va1, 8); SA_PVG(va1, 1);
          SA_TRG(va1, 3); SA_TRW(va0, 8); SA_PVG(va0, 2);
          SA_TRW(va1, 0); SA_PVG(va1, 3);
#undef SA_TRG
#undef SA_TRW
#undef SA_PVG
        }
        { const int nb = bo + SA_BUF; const int nb2 = bo2 + SA_BUF; bo = nb >= 3 * SA_BUF ? 0 : nb; bo2 = nb2 >= 3 * SA_BUF ? 0 : nb2; }
    }
    __syncthreads();
    float lt = l_run; lt += __shfl_xor(lt, 16); lt += __shfl_xor(lt, 32);
    const float inv = 1.f / lt;
    const bf16_t* wuv = WSP(bf16_t, WS_WUVT) + (size_t)(head * 128 + l15) * 512 + dvh * 256 + 4 * g;
    f32x4 oe[8]; for (int e = 0; e < 8; ++e) oe[e] = (f32x4){0.f, 0.f, 0.f, 0.f};
#pragma unroll
    for (int i = 0; i < 8; ++i) { u32x4 bw; bw.x = pk2(o[2 * i][0] * inv, o[2 * i][1] * inv); bw.y = pk2(o[2 * i][2] * inv, o[2 * i][3] * inv); bw.z = pk2(o[2 * i + 1][0] * inv, o[2 * i + 1][1] * inv); bw.w = pk2(o[2 * i + 1][2] * inv, o[2 * i + 1][3] * inv);
        const bf16x8 bf = __builtin_bit_cast(bf16x8, bw);
#pragma unroll
        for (int e = 0; e < 8; ++e) { const bf16_t* wp = wuv + (size_t)e * 16 * 512 + 32 * i; const u32x2 a0 = *(const u32x2*)wp, a1 = *(const u32x2*)(wp + 16);
            const u32x4 aw = {a0.x, a0.y, a1.x, a1.y}; oe[e] = MFMA16(__builtin_bit_cast(bf16x8, aw), bf, oe[e]); } }
    LAS float* red = (LAS float*)lds + (wid & 3) * 2048;
    if (dvh == 1) {
#pragma unroll
        for (int e = 0; e < 8; ++e) *(LAS f32x4*)(red + (e * 64 + lane) * 4) = oe[e]; }
    __syncthreads();
    if (dvh == 0) { bf16_t* orow = Q + (size_t)(R_SAMPLE + b * 16 + l15) * QP + head * 128 + 4 * g;
#pragma unroll
        for (int e = 0; e < 8; ++e) { const f32x4 v = oe[e] + *(LAS const f32x4*)(red + (e * 64 + lane) * 4); u32x2 w; w.x = pk2(v[0], v[1]); w.y = pk2(v[2], v[3]); *(u32x2*)(orow + 16 * e) = w; } }
    __syncthreads();
#undef SA_DMA
}
constexpr int GL_QP = 528, GL_KP = 144, GL_VP = 144;
constexpr int GL_QD = 0, GL_KET = 64 * GL_QP, GL_V = GL_KET + 256 * GL_KP, GL_DEC = GL_V + 64 * GL_VP, GL_OP = GL_DEC + 1024, GL_END = GL_OP + 16384;
static_assert(GL_END <= RING_BYTES, "GLA LDS");

struct GlaStage { u32x4 q[4], e[4], v; float d; };
template <bool SAMPLE>
__device__ __forceinline__ void gla_unit(const Ptrs& P, LAS unsigned char* lds, const int wid, int h, int dvb, int b  ) {
    const int lane = lane_now(), tid = wid * 64 + lane, l15 = lane & 15, g = lane >> 4, dg = wid & 3, kh = wid >> 2;
    const bf16_t* H = WSP(bf16_t, WS_H); const bf16_t* KET = WSP(bf16_t, WS_KET); bf16_t* OG = WSP(bf16_t, WS_OG);
    const int dvcol = h * 512 + dvb * 64;
    f32x4 S[8];
    if (SAMPLE) { const char* s0 = (const char*)(P.state_gla + ((size_t)(b * 4 + h) * 256 + 128 * kh) * 512 + dvb * 64 + 16 * dg); const unsigned vo = (unsigned)((4 * g) * 512 + l15) * 4u;
#pragma unroll
        for (int i = 0; i < 8; ++i) {
#pragma unroll
            for (int r = 0; r < 4; ++r) S[i][r] = *(const float*)(s0 + (vo + (unsigned)((16 * i + r) * 2048)));
            asm volatile("" ::: "memory"); } }
    else {
#pragma unroll
        for (int i = 0; i < 8; ++i) S[i] = (f32x4){0.f, 0.f, 0.f, 0.f}; }
    constexpr int nch = SAMPLE ? 1 : 129;
    const unsigned oq = (unsigned)((tid >> 5) * NH + (tid & 31) * 8) * 2u, oe = (unsigned)((tid >> 3) * 64 + (tid & 7) * 8) * 2u, ov = (unsigned)((tid >> 3) * NH + (tid & 7) * 8) * 2u;
    const u32x4 z4 = (u32x4){0u, 0u, 0u, 0u};
#define GL_JB(ci) (SAMPLE ? 128 + (b >> 2) : ((ci) == 0 ? 136 : (ci) - 1))
#define GL_LOAD(st, ci) do { const int jb_ = GL_JB(ci); const int row0_ = SAMPLE ? R_SAMPLE + 16 * b : 64 * jb_; const char* hq = (const char*)(H + (size_t)row0_ * NH + h * 256); \
        const char* kb_ = (const char*)(KET + ((size_t)(jb_ * 4 + h) * 256) * 64 + (SAMPLE ? 16 * (b & 3) : 0)); const char* hv = (const char*)(H + (size_t)row0_ * NH + HC_V + dvcol); \
        _Pragma("unroll") for (int i = 0; i < 4; ++i) { if (SAMPLE && i > 0) st.q[i] = z4; else st.q[i] = *(const u32x4*)(hq + (oq + (unsigned)i * (16u * NH * 2u))); } \
        _Pragma("unroll") for (int i = 0; i < 4; ++i) { st.e[i] = *(const u32x4*)(kb_ + (oe + (unsigned)i * 8192u)); if (SAMPLE && (tid & 7) >= 2) st.e[i] = z4; } \
        st.v = *(const u32x4*)(hv + ov); if (SAMPLE && tid >= 128) st.v = z4; \
        st.d = 0.f; if (tid < 256) st.d = SAMPLE ? WSP(float, WS_DECS)[b * 1024 + h * 256 + tid] : WSP(float, WS_DECP)[jb_ * 1024 + h * 256 + tid]; } while (0)
#define GL_WRITE(st) do { \
        _Pragma("unroll") for (int i = 0; i < 4; ++i) { const int idx = tid + i * 512, r = idx >> 5, c = idx & 31; *(LAS u32x4*)(lds + GL_QD + r * GL_QP + c * 16) = st.q[i]; } \
        _Pragma("unroll") for (int i = 0; i < 4; ++i) { const int idx = tid + i * 512, dk = idx >> 3, c = idx & 7; *(LAS u32x4*)(lds + GL_KET + dk * GL_KP + c * 16) = st.e[i]; } \
        *(LAS u32x4*)(lds + GL_V + (tid >> 3) * GL_VP + (tid & 7) * 16) = st.v; \
        if (tid < 256) *(LAS float*)(lds + GL_DEC + tid * 4) = st.d; } while (0)
#define GL_COMPUTE_S() do { bf16x8 vf[2]; \
        _Pragma("unroll") for (int k2 = 0; k2 < 2; ++k2) { LAS const unsigned char* vp = lds + GL_V + (32 * k2 + 8 * g + (l15 >> 2)) * GL_VP + (16 * dg + 4 * (l15 & 3)) * 2; vf[k2] = cat8(lds_tr(vp), lds_tr(vp + 4 * GL_VP)); } \
        _Pragma("unroll") for (int k4 = 0; k4 < 4; ++k4) { u32x4 sw; sw.x = pk2(S[2 * k4][0], S[2 * k4][1]); sw.y = pk2(S[2 * k4][2], S[2 * k4][3]); sw.z = pk2(S[2 * k4 + 1][0], S[2 * k4 + 1][1]); sw.w = pk2(S[2 * k4 + 1][2], S[2 * k4 + 1][3]); \
            const bf16x8 sf = __builtin_bit_cast(bf16x8, sw); \
            o[0] = MFMA16(sf, *(LAS const bf16x8*)(lds + GL_QD + l15 * GL_QP + (32 * (4 * kh + k4) + 8 * g) * 2), o[0]); } \
        if (kh == 1) *(LAS f32x4*)(lds + GL_OP + ((dg * 4) * 64 + lane) * 16) = o[0]; \
        _Pragma("unroll") for (int i = 0; i < 8; ++i) { const f32x4 d4 = *(LAS const f32x4*)(lds + GL_DEC + (128 * kh + 16 * i + 4 * g) * 4); S[i] *= d4; } \
        _Pragma("unroll") for (int i = 0; i < 8; ++i) { const bf16x8 af = *(LAS const bf16x8*)(lds + GL_KET + (128 * kh + 16 * i + l15) * GL_KP + (8 * g) * 2); S[i] = MFMA16(af, vf[0], S[i]); } \
    } while (0)
#define GL_RD(dst, n_) do { if ((n_) < 16) asm volatile("ds_read_b128 %0, %1 offset:%2" : "=v"(dst) : "v"(aq_), "n"(((n_) & 3) * 16 * GL_QP + ((n_) >> 2) * 64)); \
        else if ((n_) < 24) asm volatile("ds_read_b128 %0, %1 offset:%2" : "=v"(dst) : "v"(ad_), "n"(((n_) - 16) * 64)); \
        else asm volatile("ds_read_b128 %0, %1 offset:%2" : "=v"(dst) : "v"(ak_), "n"((((n_) - 24) >> 1) * 16 * GL_KP + (((n_) - 24) & 1) * 64)); } while (0)
#define GL_COMPUTE_P() do { \
        const unsigned aq_ = (unsigned)(size_t)(lds + GL_QD + l15 * GL_QP + (128 * kh + 8 * g) * 2), ad_ = (unsigned)(size_t)(lds + GL_DEC + (128 * kh + 4 * g) * 4); \
        const unsigned ak_ = (unsigned)(size_t)(lds + GL_KET + (128 * kh + l15) * GL_KP + 16 * g), av_ = (unsigned)(size_t)(lds + GL_V + (8 * g + (l15 >> 2)) * GL_VP + (16 * dg + 4 * (l15 & 3)) * 2); \
        s16x4 t0_, t1_, t2_, t3_; \
        asm volatile("ds_read_b64_tr_b16 %0, %1 offset:%2" : "=v"(t0_) : "v"(av_), "n"(0)); asm volatile("ds_read_b64_tr_b16 %0, %1 offset:%2" : "=v"(t1_) : "v"(av_), "n"(4 * GL_VP)); \
        asm volatile("ds_read_b64_tr_b16 %0, %1 offset:%2" : "=v"(t2_) : "v"(av_), "n"(32 * GL_VP)); asm volatile("ds_read_b64_tr_b16 %0, %1 offset:%2" : "=v"(t3_) : "v"(av_), "n"(36 * GL_VP)); \
        u32x4 R_[8]; \
        _Pragma("unroll") for (int n = 0; n < 8; ++n) GL_RD(R_[n], n); \
        asm volatile("s_waitcnt lgkmcnt(7)" : "+v"(R_[0]), "+v"(t0_), "+v"(t1_), "+v"(t2_), "+v"(t3_)); \
        const bf16x8 vf0_ = cat8(t0_, t1_), vf1_ = cat8(t2_, t3_); bf16x8 sf_ = vf0_; \
        _Pragma("unroll") for (int n = 0; n < 40; ++n) { \
            if (n > 0) { if (n <= 32) asm volatile("s_waitcnt lgkmcnt(7)" : "+v"(R_[n & 7])); else if (n == 33) asm volatile("s_waitcnt lgkmcnt(6)" : "+v"(R_[n & 7])); else if (n == 34) asm volatile("s_waitcnt lgkmcnt(5)" : "+v"(R_[n & 7])); \
                else if (n == 35) asm volatile("s_waitcnt lgkmcnt(4)" : "+v"(R_[n & 7])); else if (n == 36) asm volatile("s_waitcnt lgkmcnt(3)" : "+v"(R_[n & 7])); else if (n == 37) asm volatile("s_waitcnt lgkmcnt(2)" : "+v"(R_[n & 7])); \
                else if (n == 38) asm volatile("s_waitcnt lgkmcnt(1)" : "+v"(R_[n & 7])); else asm volatile("s_waitcnt lgkmcnt(0)" : "+v"(R_[n & 7])); } \
            if (n < 16) { const int k4 = n >> 2; \
                if ((n & 3) == 0) { u32x4 sw; sw.x = pk2(S[2 * k4][0], S[2 * k4][1]); sw.y = pk2(S[2 * k4][2], S[2 * k4][3]); sw.z = pk2(S[2 * k4 + 1][0], S[2 * k4 + 1][1]); sw.w = pk2(S[2 * k4 + 1][2], S[2 * k4 + 1][3]); sf_ = __builtin_bit_cast(bf16x8, sw); } \
                o[n & 3] = MFMA16(sf_, __builtin_bit_cast(bf16x8, R_[n & 7]), o[n & 3]); } \
            else if (n < 24) { S[n - 16] *= __builtin_bit_cast(f32x4, R_[n & 7]); } \
            else { const int i = (n - 24) >> 1; S[i] = MFMA16(__builtin_bit_cast(bf16x8, R_[n & 7]), ((n - 24) & 1) ? vf1_ : vf0_, S[i]); } \
            if (n + 8 < 40) GL_RD(R_[n & 7], n + 8); \
            if (n == 15 && kh == 1) { _Pragma("unroll") for (int ct = 0; ct < 4; ++ct) *(LAS f32x4*)(lds + GL_OP + ((dg * 4 + ct) * 64 + lane) * 16) = o[ct]; } } \
    } while (0)
#define GL_STEP(st, ci, cn) do { GL_WRITE(st); __syncthreads(); if (!SAMPLE && (cn) < nch) GL_LOAD(st, cn); \
        const int jb = GL_JB(ci); const int row0 = SAMPLE ? R_SAMPLE + 16 * b : 64 * jb; \
        f32x4 o[4]; \
        _Pragma("unroll") for (int ct = 0; ct < 4; ++ct) o[ct] = (f32x4){0.f, 0.f, 0.f, 0.f}; \
        if (SAMPLE) { GL_COMPUTE_S(); } else { GL_COMPUTE_P(); } \
        __syncthreads(); \
        if (kh == 0) { _Pragma("unroll") for (int ct = 0; ct < 4; ++ct) { if (SAMPLE && ct > 0) continue; const f32x4 v = o[ct] + *(LAS const f32x4*)(lds + GL_OP + ((dg * 4 + ct) * 64 + lane) * 16); \
            u32x2 w; w.x = pk2(v[0], v[1]); w.y = pk2(v[2], v[3]); *(u32x2*)(OG + (size_t)(row0 + 16 * ct + l15) * DM + dvcol + 16 * dg + 4 * g) = w; } } \
    } while (0)
    GlaStage X;
    GL_LOAD(X, 0);
    if (SAMPLE) { GL_STEP(X, 0, 1); }
    else {
        GlaStage Y;
        GL_LOAD(Y, 1);
        for (int ci = 0; ci < nch - 1; ci += 2) {
            GL_STEP(X, ci, ci + 2); GL_STEP(Y, ci + 1, ci + 3);
        }
        GL_STEP(X, nch - 1, nch + 1);
    }
    __syncthreads();
    { char* so = (char*)(P.out + (SAMPLE ? O_GSS + (size_t)(b * 4 + h) * 256 * 512 : O_GSP + (size_t)h * 256 * 512) + (size_t)(128 * kh) * 512 + dvb * 64 + 16 * dg);
      const int ln = lane_now(); const unsigned vo = (unsigned)((4 * (ln >> 4)) * 512 + (ln & 15)) * 4u;
#pragma unroll
      for (int i = 0; i < 8; ++i) {
#pragma unroll
        for (int r = 0; r < 4; ++r) *(float*)(so + (vo + (unsigned)((16 * i + r) * 2048))) = S[i][r];
        asm volatile("" ::: "memory"); } }
#undef GL_LOAD
#undef GL_WRITE
#undef GL_STEP
#undef GL_COMPUTE_S
#undef GL_COMPUTE_P
#undef GL_RD
#undef GL_JB
}
#ifndef UNIT_MASK
#define UNIT_MASK 15
#endif
#ifndef MK_N_LAUNCHES
#define MK_N_LAUNCHES 1
#endif
constexpr int N_PHASES = 10;
struct Args { const float* in[24]; float* out; unsigned char* ws; int ph_lo, ph_hi; };

__global__ void __launch_bounds__(512, 2) fwd_megakernel(Args args) {
    extern __shared__ __attribute__((aligned(16))) unsigned char lds_raw[];
    LAS unsigned char* lds = (LAS unsigned char*)lds_raw;
    volatile LAS unsigned* MISC = (volatile LAS unsigned*)(lds + MISC_OFF);
    Ptrs P;
    P.x_prompt = args.in[0]; P.x_sample = args.in[1]; P.cache_lat = args.in[2]; P.cache_krope = args.in[3]; P.state_gla = args.in[4]; P.cache_conv = args.in[5]; P.meta = args.in[6]; P.g_mix = args.in[7];
    P.w_in = args.in[8]; P.w_a2 = args.in[9]; P.b_a = args.in[10]; P.g_gla = args.in[11]; P.g_q = args.in[12]; P.w_uq = args.in[13]; P.g_kv = args.in[14]; P.w_uk = args.in[15]; P.w_uv = args.in[16]; P.w_o = args.in[17];
    P.g_ffn = args.in[18]; P.w_up = args.in[19]; P.conv_w = args.in[20]; P.conv_b = args.in[21]; P.w_down = args.in[22]; P.final_norm = args.in[23]; P.out = args.out; P.ws = args.ws;
    WaveCtx C; C.lds = lds; C.wave = __builtin_amdgcn_readfirstlane(threadIdx.x >> 6);
    const int G = gridDim.x, bx = blockIdx.x;
    C.gw = bx * 8 + C.wave; C.ngw = G * 8;
    if (threadIdx.x < 32) MISC[threadIdx.x] = 0u;
    const bool tid0 = (threadIdx.x == 0);
    __syncthreads();
    unsigned* ctl = (unsigned*)(P.ws + WS_CTL);
    const int lo = args.ph_lo, hi = args.ph_hi;
    XcdBarrier bar; bar.bar = ctl + CW_BAR; bar.x = 0; bar.st = nullptr;
    if (hi - lo > 1) bar = xcd_barrier_post(ctl + CW_BAR, MISC + 8, tid0);
#ifndef PH_MASK
#define PH_MASK 0x3ff
#endif
#define IN(k) (((PH_MASK >> (k)) & 1) && lo <= (k) && (k) < hi)
#ifndef PROBE_MASK
#define PROBE_MASK 0
#endif
    unsigned long long tps_ = (PROBE_MASK != 0) ? __builtin_amdgcn_s_memrealtime() : 0ull;
#define SEAM(k) do { if (IN(k) && IN((k) + 1)) xcd_barrier(bar, C.wave); \
        if (PROBE_MASK != 0) { const unsigned long long t1_ = __builtin_amdgcn_s_memrealtime(); if ((PROBE_MASK >> (k)) & 1) { while (__builtin_amdgcn_s_memrealtime() - t1_ < t1_ - tps_) __builtin_amdgcn_s_sleep(8); } tps_ = __builtin_amdgcn_s_memrealtime(); } } while (0)

    if (IN(0)) { p0_prologue(P, C); }
    SEAM(0);
    if (IN(1)) {
        { SchedPlain S; S.o.init(NMT, NH / 256, G, bx); S.A = (const char*)WSP(bf16_t, WS_XBF); S.Bt = (const char*)WSP(bf16_t, WS_W1T); S.a_tile = (size_t)256 * DM * 2; S.b_tile = (size_t)256 * DM * 2; S.nt = DM / 64;
          EpiInProj E{WSP(bf16_t, WS_H), WSP(float, WS_RSX), WSP(float, WS_SS)};
          pg8::gemm_phase(lds, C.wave, DM, DM, S, E); }
        p1_wabs(P, C);
        for (;;) { if (C.wave == 0 && lane_now() == 0) MISC[0] = __hip_atomic_fetch_add(ctl + CW_QUEUE1, 8u, RLX_AGENT);
            __syncthreads(); const int base = (int)MISC[0]; __syncthreads();
            if (base >= I_CACHE) break;
            const int it = base + C.wave; if (it < I_CACHE) cache_conv_item(P, it, lane_now()); }
    }
    SEAM(1);
    if (IN(2)) {
#ifdef PROBE_P2R
        const unsigned long long tr0_ = __builtin_amdgcn_s_memrealtime();
#endif
        p2_rows(P, C);
#ifdef PROBE_P2R
        { const unsigned long long tr1_ = __builtin_amdgcn_s_memrealtime(); while (__builtin_amdgcn_s_memrealtime() - tr1_ < tr1_ - tr0_) __builtin_amdgcn_s_sleep(8); }
#endif
        __syncthreads();
        SchedP2 S{G, bx, (const char*)P.ws};
        EpiP2 E{WSP(bf16_t, WS_Q), WSP(bf16_t, WS_KV), WSP(bf16_t, WS_QLAT), WSP(bf16_t, WS_WABS), WSP(float, WS_SS), WSP(f32x2, WS_ROPE)};
        pg8::gemm_phase(lds, C.wave, NH, 512, S, E);
    }
    SEAM(2);
    if (IN(3)) {
        for (;;) {
            if (C.wave == 0 && lane_now() == 0) MISC[0] = __hip_atomic_fetch_add(ctl + CW_QUEUE, 1u, RLX_AGENT);
            __syncthreads();
            const int idx = (int)MISC[0];
            __syncthreads();
            if (idx >= 1712) break;
            if (idx < 32) {
#ifdef PROBE_GLA
                const unsigned long long tg0_ = __builtin_amdgcn_s_memrealtime();
#endif
                if (UNIT_MASK & 1) gla_unit<false>(P, lds, C.wave, idx >> 3, idx & 7, 0);
#ifdef PROBE_GLA
                { const unsigned long long tg1_ = __builtin_amdgcn_s_memrealtime(); while (__builtin_amdgcn_s_memrealtime() - tg1_ < tg1_ - tg0_) __builtin_amdgcn_s_sleep(8); }
#endif
            }
            else if (idx < 160) { const int s = idx - 32;
#ifdef PROBE_SATTS
                const unsigned long long ts0_ = __builtin_amdgcn_s_memrealtime();
#endif
                if (UNIT_MASK & 4) attn_sample_unit(P, lds, C.wave, s >> 2, s & 3);
#ifdef PROBE_SATTS
                { const unsigned long long ts1_ = __builtin_amdgcn_s_memrealtime(); while (__builtin_amdgcn_s_memrealtime() - ts1_ < ts1_ - ts0_) __builtin_amdgcn_s_sleep(8); }
#endif
#ifdef PROBE_SATT2
                __syncthreads(); attn_sample_unit(P, lds, C.wave, s >> 2, s & 3);
#endif
            }
            else if (idx < 688) { int h, qrow0, npr, tl;
                if (idx < 176) { h = idx - 160; qrow0 = R_META; npr = 0; tl = 0; }
                else { const int a = idx - 176, qb = 31 - (a >> 4); h = a & 15; qrow0 = 256 * qb; npr = 4 * qb + 4; tl = 4 * qb; }
#ifdef PROBE_ATT
                const unsigned long long ta0_ = __builtin_amdgcn_s_memrealtime();
#endif
                if (UNIT_MASK & 2) attn_prompt_unit(P, lds, C.wave, h, qrow0, npr, tl);
#ifdef PROBE_ATT
                { const unsigned long long ta1_ = __builtin_amdgcn_s_memrealtime(); while (__builtin_amdgcn_s_memrealtime() - ta1_ < ta1_ - ta0_) __builtin_amdgcn_s_sleep(8); }
#endif
            }
            else { const int gs = idx - 688; if (UNIT_MASK & 8) gla_unit<true>(P, lds, C.wave, (gs >> 3) & 3, gs & 7, gs >> 5);
#ifdef PROBE_GLAS2
                __syncthreads(); gla_unit<true>(P, lds, C.wave, (gs >> 3) & 3, gs & 7, gs >> 5);
#endif
            }
        }
    }
    SEAM(3);
    if (IN(4)) {
        for (;;) { if (C.wave == 0 && lane_now() == 0) MISC[0] = __hip_atomic_fetch_add(ctl + CW_QUEUE4, 1u, RLX_AGENT);
            __syncthreads(); const int u = (int)MISC[0]; __syncthreads();
            if (u >= 137 * 4 + I_DN / 8) break;
            if (u < 137 * 4) p4_unit(P, lds, C.wave, u >> 2, u & 3);
            else ffn_wconv_item(P, lds + C.wave * 16384, I_UP + (u - 137 * 4) * 8 + C.wave, lane_now()); }
    }
    SEAM(4);
    if (IN(5)) {
        SchedPlain S; S.o.init(NMT, DM / 256, G, bx); S.A = (const char*)WSP(bf16_t, WS_MERGED); S.Bt = (const char*)WSP(bf16_t, WS_WOT); S.a_tile = (size_t)256 * DM * 2; S.b_tile = (size_t)256 * DM * 2; S.nt = DM / 64;
        EpiOut E{P.x_prompt, P.x_sample, P.meta, P.out, WSP(float, WS_X2M), WSP(bf16_t, WS_X2B), WSP(float, WS_SS2), ctl + CW_SKF5};
        pg8::gemm_phase(lds, C.wave, DM, DM, S, E);
        { LAS unsigned char* scr = lds + C.wave * 16384;
          for (;;) { if (C.wave == 0 && lane_now() == 0) MISC[0] = __hip_atomic_fetch_add(ctl + CW_QUEUE2, 8u, RLX_AGENT);
              __syncthreads(); const int base = (int)MISC[0]; __syncthreads();
              if (base >= I_UP) break;
              const int it = base + C.wave; if (it < I_UP) ffn_wconv_item(P, scr, it, lane_now()); } }
    }
    SEAM(5);
    if (IN(6)) {
        SchedPlain S; S.o.init(34, DFF2 / 256, G, bx); S.A = (const char*)WSP(bf16_t, WS_X2B); S.Bt = (const char*)WSP(bf16_t, WS_WUPT); S.a_tile = (size_t)256 * DM * 2; S.b_tile = (size_t)256 * DM * 2; S.nt = DM / 64; S.quarter = 1;
        EpiUp E{WSP(bf16_t, WS_H)};
        pg8::gemm_phase(lds, C.wave, DM, DM, S, E);
        for (;;) { if (C.wave == 0 && lane_now() == 0) MISC[0] = __hip_atomic_fetch_add(ctl + CW_QUEUE6S, 8u, RLX_AGENT);
            __syncthreads(); const int base = (int)MISC[0]; __syncthreads();
            if (base >= I_SKU) break;
            const int it = base + C.wave; if (it < I_SKU) skinny_up_item(P, it, lane_now()); }
    }
    SEAM(6);
    if (IN(7)) { p7_conv(P, C); }
    SEAM(7);
    if (IN(8)) {
        SchedSplitTail<EpiDown::NS> S; S.o.init(34, DM / 256, G, bx); S.A = (const char*)WSP(bf16_t, WS_GATE); S.Bt = (const char*)WSP(bf16_t, WS_WDT); S.a_tile = (size_t)256 * DFF * 2; S.b_tile = (size_t)256 * DFF * 2; S.nt = DFF / 64;
        EpiDown E{P.out, ctl + CW_SKF8, lds};
        pg8::gemm_phase(lds, C.wave, DFF, DFF, S, E);
    }
    SEAM(8);
    if (IN(9)) { p9_final(P, C); }
    SEAM(9);
#ifdef PROBE_BAR
    for (int q_ = 0; q_ < 10; ++q_) xcd_barrier(bar, C.wave);
#endif
#undef IN
#undef SEAM
}

extern "C" void kernel_launch(void* const* d_in, const int* in_sizes, int n_in, void* d_out, int out_size, void* d_ws, size_t ws_size, hipStream_t stream) {
    static int grid = 0;
    if (grid == 0) {
        if (n_in != 24 || out_size != (int)O_END || ws_size < WS_END) { fprintf(stderr, "kernel_launch: shape mismatch: n_in %d out %d ws %zu (need 24, %zu, >= %zu); nothing launched\n", n_in, out_size, ws_size, (size_t)O_END, (size_t)WS_END); grid = -1; return; }
        int dev = 0, cus = 0, per_cu = 0;
        if (hipGetDevice(&dev) != hipSuccess || hipDeviceGetAttribute(&cus, hipDeviceAttributeMultiprocessorCount, dev) != hipSuccess) { fprintf(stderr, "kernel_launch: device query failed\n"); grid = -1; return; }
        if (hipFuncSetAttribute((const void*)fwd_megakernel, hipFuncAttributeMaxDynamicSharedMemorySize, LDS_BYTES) != hipSuccess) { fprintf(stderr, "kernel_launch: hipFuncSetAttribute failed\n"); grid = -1; return; }
        if (hipOccupancyMaxActiveBlocksPerMultiprocessor(&per_cu, (const void*)fwd_megakernel, 512, LDS_BYTES) != hipSuccess || per_cu < 1) { fprintf(stderr, "kernel_launch: occupancy query reports %d blocks per CU\n", per_cu); per_cu = 1; }
        (void)hipGetLastError();
        grid = cus;
        fprintf(stderr, "kernel_launch: grid %d (cus %d, occupancy %d/CU), ws %zu\n", grid, cus, per_cu, ws_size);
    }
    if (grid < 0) return;
    if (hipMemsetAsync((char*)d_ws + WS_CTL, 0, CTL_ZERO_BYTES, stream) != hipSuccess) { fprintf(stderr, "kernel_launch: memset failed\n"); return; }
    Args a{};
    for (int i = 0; i < 24; ++i) a.in[i] = (const float*)d_in[i];
    a.out = (float*)d_out; a.ws = (unsigned char*)d_ws;
    if (MK_N_LAUNCHES == 1) { a.ph_lo = 0; a.ph_hi = N_PHASES; hipLaunchKernelGGL(fwd_megakernel, dim3(grid), dim3(512), LDS_BYTES, stream, a); }
    else { for (int p = 0; p < N_PHASES; ++p) { a.ph_lo = p; a.ph_hi = p + 1; hipLaunchKernelGGL(fwd_megakernel, dim3(grid), dim3(512), LDS_BYTES, stream, a); } }
    const hipError_t le = hipPeekAtLastError();
    if (le != hipSuccess) fprintf(stderr, "kernel_launch: launch failed: %s\n", hipGetErrorName(le));
}
```

```cpp
#include <hip/hip_runtime.h>
#include <cstdio>
#include <cstdint>

#define LAS __attribute__((address_space(3)))
#define GAS __attribute__((address_space(1)))
typedef unsigned short bf16_t;
typedef short bf16x8 __attribute__((ext_vector_type(8)));
typedef short s16x4 __attribute__((ext_vector_type(4)));
typedef float f32x2 __attribute__((ext_vector_type(2)));
typedef float f32x4 __attribute__((ext_vector_type(4)));
typedef float f32x16 __attribute__((ext_vector_type(16)));
typedef unsigned u32x2 __attribute__((ext_vector_type(2)));
typedef unsigned u32x4 __attribute__((ext_vector_type(4)));
typedef __bf16 bf16x2_t __attribute__((ext_vector_type(2)));
typedef GAS unsigned gu32;

#define MFMA32(a, b, c) __builtin_amdgcn_mfma_f32_32x32x16_bf16((a), (b), (c), 0, 0, 0)
#define MFMA16(a, b, c) __builtin_amdgcn_mfma_f32_16x16x32_bf16((a), (b), (c), 0, 0, 0)
#define RLX_AGENT __ATOMIC_RELAXED, __HIP_MEMORY_SCOPE_AGENT

__device__ __forceinline__ unsigned pk2(float lo, float hi) { f32x2 v = {lo, hi}; bf16x2_t b = __builtin_convertvector(v, bf16x2_t); return __builtin_bit_cast(unsigned, b); }
__device__ __forceinline__ float bflo(unsigned u) { return __uint_as_float(u << 16); }
__device__ __forceinline__ float bfhi(unsigned u) { return __uint_as_float(u & 0xffff0000u); }
__device__ __forceinline__ float bf1(bf16_t u) { return __uint_as_float(((unsigned)u) << 16); }
__device__ __forceinline__ bf16_t f2bf(float f) { return (bf16_t)(pk2(f, 0.f) & 0xffffu); }
__device__ __forceinline__ int lane_now() { int l; asm volatile("v_mbcnt_lo_u32_b32 %0, -1, 0\n\tv_mbcnt_hi_u32_b32 %0, -1, %0" : "=v"(l)); return l; }
__device__ __forceinline__ float wave_sum(float v) {
#pragma unroll
    for (int o = 1; o < 64; o <<= 1) v += __shfl_xor(v, o);
    return v;
}
__device__ __forceinline__ float sigmoidf_(float x) { return 1.f / (1.f + __expf(-x)); }
__device__ __forceinline__ s16x4 lds_tr(LAS const unsigned char* p) { typedef short v4i16_t __attribute__((ext_vector_type(4))); return __builtin_bit_cast(s16x4, __builtin_amdgcn_ds_read_tr16_b64_v4i16((LAS v4i16_t*)p)); }
__device__ __forceinline__ bf16x8 cat8(s16x4 lo, s16x4 hi) { return (bf16x8){lo[0], lo[1], lo[2], lo[3], hi[0], hi[1], hi[2], hi[3]}; }

constexpr int DM = 2048, T_P = 8192, N_META = 16, DEC_B = 32, DEC_T = 16, PAST = 1024, TK_S = PAST + DEC_T;
constexpr int R_SAMPLE = 8192, R_META = 8704, M_REAL = 8720, M_PAD = 8960, NMT = 35;
constexpr int NH = 11520;
constexpr int HC_Q = 0, HC_K = 1024, HC_V = 2048, HC_R = 4096, HC_CQ = 6144, HC_CKV = 6656, HC_GA = 7168, HC_GB = 9216, HC_KPE = 11264, HC_AG = 11328;
constexpr int IN_COLS = 11344;
constexpr int QP = 3072;
constexpr int DFF = 5632, DFF2 = 11264;
constexpr float EPS = 1e-6f;
constexpr float QSCALE = 0.07216878364870322f * 1.4426950408889634f;

constexpr size_t O_YP = 0, O_YS = 16777216, O_LATP = 17825792, O_KRP = 22028288, O_GSP = 22553600, O_CVP = 23077888, O_LATS = 23100416, O_KRS = 23362560, O_GSS = 23395328, O_CVS = 40172544, O_END = 40893440;

constexpr size_t MiB = 1u << 20;
constexpr size_t WS_CTL = 0, CTL_ZERO_BYTES = 256 * 1024;
constexpr size_t WS_RSX = 1 * MiB;
constexpr size_t WS_SS = 1 * MiB + 256 * 1024;
constexpr size_t WS_SS2 = 2 * MiB;
constexpr size_t WS_ROPE = 3 * MiB + 512 * 1024;
constexpr size_t WS_DECP = 6 * MiB;
constexpr size_t WS_DECS = 6 * MiB + 640 * 1024;
constexpr size_t WS_KPE = 6 * MiB + 768 * 1024;
constexpr size_t WS_WOT = 8 * MiB, WS_WUVT = 16 * MiB, WS_WQT = 18 * MiB, WS_WKVT = 21 * MiB, WS_WUKN = 25 * MiB, WS_WUQN = 27 * MiB, WS_WABS = 30 * MiB, WS_X2M = 38 * MiB;
constexpr size_t WS_H = 40 * MiB;
constexpr size_t WS_R3 = 238 * MiB;
constexpr size_t WS_XBF = WS_R3;
constexpr size_t WS_Q = WS_R3, WS_SKL = WS_R3 + 53 * MiB, WS_SKP = WS_R3 + 86 * MiB, WS_QLAT = WS_R3 + 91 * MiB;
constexpr size_t WS_X2B = WS_R3, WS_WUPT = WS_R3 + 53 * MiB;
constexpr size_t WS_GATE = WS_R3;
constexpr size_t WS_R4 = 338 * MiB;
constexpr size_t WS_W1T = WS_R4;
constexpr size_t WS_KV = WS_R4, WS_KET = WS_R4 + 66 * MiB;
constexpr size_t WS_MERGED = WS_R4, WS_WDT = WS_R4 + 35 * MiB;
constexpr size_t WS_OG = 422 * MiB;
constexpr size_t WS_END = 457 * MiB;
static_assert(WS_W1T + (size_t)NH * DM * 2 <= WS_OG && WS_XBF + (size_t)M_PAD * DM * 2 <= WS_SKL && WS_QLAT + (size_t)512 * 8192 * 2 <= WS_R4 && WS_SKL + (size_t)DEC_B * TK_S * 512 * 2 <= WS_SKP && WS_SKP + (size_t)DEC_B * TK_S * 64 * 2 <= WS_QLAT, "R3 map");
static_assert(WS_Q + (size_t)M_PAD * QP * 2 <= WS_SKL && WS_WUPT + (size_t)DFF2 * DM * 2 <= WS_R4 && WS_GATE + (size_t)M_PAD * DFF * 2 <= WS_R4, "R3 map 2");
static_assert(WS_KV + (size_t)33 * 256 * 4096 * 2 <= WS_KET && WS_KET + (size_t)140 * 4 * 256 * 64 * 2 <= WS_OG && WS_WDT + (size_t)DM * DFF * 2 <= WS_OG && WS_OG + (size_t)M_PAD * DM * 2 <= WS_END && WS_MERGED + (size_t)M_PAD * DM * 2 <= WS_WDT, "R4 map");
static_assert(WS_H + (size_t)M_PAD * NH * 2 <= WS_R3 && WS_WABS + (size_t)8192 * 512 * 2 <= WS_X2M && WS_X2M + 2 * MiB <= WS_H, "H map");
constexpr int CW_BAR = 1024;
constexpr int CW_QUEUE = 8192;
constexpr int CW_QUEUE2 = 8256;
constexpr int CW_QUEUE6S = 8512;
constexpr int CW_QUEUE6 = 8448;
constexpr int CW_QUEUE1 = 8320;
constexpr int CW_QUEUE4 = 8384;
constexpr int CW_SKF5 = 9216, CW_SKF8 = 10240;

constexpr int RING_BYTES = 131072, MISC_OFF = 163584, LDS_BYTES = 163840;
#define XB_TMO      128
#define XB_XCNT(j)  (256  + 64 * (j))
#define XB_XSUB(j)  (1280 + 64 * (j))
#define XB_XGEN(j)  (2304 + 64 * (j))
#define XB_TOP      3328
#define XB_TOPGEN   3392
#define XCD_BAR_WORDS 3456
#define XB_SPIN_CAP (1u << 18)
__device__ __forceinline__ unsigned xb_ld(unsigned* p)              { return __hip_atomic_load(p, __ATOMIC_RELAXED, __HIP_MEMORY_SCOPE_AGENT); }
__device__ __forceinline__ unsigned xb_add(unsigned* p, unsigned v) { return __hip_atomic_fetch_add(p, v, __ATOMIC_RELAXED, __HIP_MEMORY_SCOPE_AGENT); }
__device__ __forceinline__ unsigned xb_xcc_id() { return (unsigned)__builtin_amdgcn_s_getreg((3 << 11) | 20) & 0xFu; }
#define XB_SPIN(cond, bar) do { unsigned _sp = 0; while (cond) { __builtin_amdgcn_s_sleep(1); \
    if ((++_sp & 255u) == 0u) { if (xb_ld(&(bar)[XB_TMO])) break; if (_sp > XB_SPIN_CAP) { atomicAdd(&(bar)[XB_TMO], 1u); break; } } } } while (0)
struct XcdBarrier { unsigned* bar; unsigned x; volatile LAS unsigned* st; };
__device__ __forceinline__ XcdBarrier xcd_barrier_post(unsigned* bar, volatile LAS unsigned* st, bool tid0) {
    XcdBarrier b; b.bar = bar; b.x = xb_xcc_id(); b.st = st;
    if (tid0) (void)xb_add(&bar[XB_XCNT(b.x)], 1u);
    return b;
}
__device__ __forceinline__ void xcd_barrier_complete(unsigned* bar, unsigned x, unsigned& nloc, unsigned& nx) {
    const unsigned G = gridDim.x * gridDim.y * gridDim.z;
    unsigned sum, cnt, mine, sp = 0u;
    for (;;) {
        sum = 0u; cnt = 0u; mine = 0u;
#pragma unroll
        for (unsigned j = 0; j < 16; ++j) { const unsigned c = xb_ld(&bar[XB_XCNT(j)]); sum += c; cnt += (c > 0u) ? 1u : 0u; mine = (j == x) ? c : mine; }
        if (sum == G) break;
        __builtin_amdgcn_s_sleep(1);
        if ((++sp & 255u) == 0u) { if (xb_ld(&bar[XB_TMO])) break; if (sp > XB_SPIN_CAP) { atomicAdd(&bar[XB_TMO], 1u); break; } }
    }
    nloc = mine > 0u ? mine : 1u; nx = cnt > 0u ? cnt : 1u;
}
__device__ __forceinline__ void xcd_barrier(const XcdBarrier& b, int wave) {
    asm volatile("s_waitcnt vmcnt(0)" ::: "memory");
    __syncthreads();
    if (wave == 0 && lane_now() == 0) {
        unsigned* bar = b.bar;
        __builtin_amdgcn_s_waitcnt(0);
        unsigned nloc = b.st[0], nx = b.st[1];
        if (nloc == 0u) { xcd_barrier_complete(bar, b.x, nloc, nx); b.st[0] = nloc; b.st[1] = nx; }
        const unsigned old = xb_add(&bar[XB_XSUB(b.x)], 1u);
        const unsigned gen = old / nloc;
        if (old + 1u == (gen + 1u) * nloc) {
            __builtin_amdgcn_fence(__ATOMIC_RELEASE, "agent");
            asm volatile("s_waitcnt vmcnt(0)" ::: "memory");
            const unsigned og = xb_add(&bar[XB_TOP], 1u);
            const unsigned tg = og / nx;
            if (og + 1u == (tg + 1u) * nx) xb_add(&bar[XB_TOPGEN], 1u);
            else XB_SPIN(xb_ld(&bar[XB_TOPGEN]) == tg, bar);
            __builtin_amdgcn_fence(__ATOMIC_ACQUIRE, "agent");
            xb_add(&bar[XB_XGEN(b.x)], 1u);
            asm volatile("s_waitcnt vmcnt(0)" ::: "memory");
        } else {
            XB_SPIN(xb_ld(&bar[XB_XGEN(b.x)]) == gen, bar);
            __builtin_amdgcn_fence(__ATOMIC_ACQUIRE, "agent");
            asm volatile("s_waitcnt vmcnt(0)" ::: "memory");
        }
    }
    __syncthreads();
}

namespace pg8 {
constexpr int BM = 256, BK = 64, HALF = 128, HTB = HALF * BK * 2, STAGE_BYTES = 8 * HTB;
__host__ __device__ __forceinline__ int lds_byte(int r, int c) { const int st = (r >> 4) * 2 + (c >> 5), rr = r & 15, cc = c & 31, ob = rr * 64 + cc * 2; return st * 1024 + (ob ^ (((ob >> 9) & 1) << 5)); }
__host__ __device__ __forceinline__ void stage_rc(int b, int& R, int& C) { const int st = b / 1024, sb = b % 1024, swz = sb ^ (((sb >> 9) & 1) << 5); R = (st >> 1) * 16 + swz / 64; C = (st & 1) * 32 + (swz % 64) / 2; }
__host__ __device__ __forceinline__ int perm32(int rho) { const int n = rho >> 4, i = rho & 15; return 8 * (i >> 2) + 4 * n + (i & 3); }
struct Unit { int pm, pn, kind, nt, part, half, nhalf; };
typedef f32x4 Acc[2][2][4][2];

struct SkRange { int hp, p0, p1; };
__device__ __forceinline__ SkRange sk_range(int ntiles, int hp, int G, int v) { const long tot = (long)ntiles * hp; SkRange r; r.hp = hp; r.p0 = (int)(tot * v / G); r.p1 = (int)(tot * (v + 1) / G); return r; }
__device__ __forceinline__ bool sk_unit(const SkRange& r, int i, int& tile, int& kt0, int& nt, int& part) {
    const int e0 = min(r.p1, (r.p0 / r.hp + 1) * r.hp); const int pos = i == 0 ? r.p0 : e0 + (i - 1) * r.hp; if (pos >= r.p1) return false;
    const int end = i == 0 ? e0 : min(r.p1, pos + r.hp), a = pos % r.hp;
    tile = pos / r.hp; kt0 = 2 * a; nt = 2 * (end - pos); part = (a == 0 && end - pos == r.hp) ? 0 : (a > 0 ? 1 : 2); return true;
}
__device__ __forceinline__ void sk_publish(unsigned* flag) { asm volatile("s_waitcnt vmcnt(0)" ::: "memory"); if (lane_now() == 0) __hip_atomic_fetch_add(flag, 1u, RLX_AGENT); }
__device__ __forceinline__ void sk_wait(unsigned* flag, int wid, unsigned need = 8u) {
    if (wid == 0) { unsigned sp = 0; while ((unsigned)__builtin_amdgcn_readfirstlane(__hip_atomic_load(flag, RLX_AGENT)) < need) { __builtin_amdgcn_s_sleep(2); if (++sp > (1u << 22)) break; }
        __builtin_amdgcn_fence(__ATOMIC_ACQUIRE, "agent"); asm volatile("s_waitcnt vmcnt(0)" ::: "memory"); }
    asm volatile("" ::: "memory"); __builtin_amdgcn_s_barrier(); asm volatile("" ::: "memory");
}
__device__ __forceinline__ void st_wt16(__amdgpu_buffer_rsrc_t rsrc, unsigned voff, f32x4 v) { __builtin_amdgcn_raw_buffer_store_b128(__builtin_bit_cast(u32x4, v), rsrc, (int)voff, 0, 16); }
__device__ __forceinline__ void st_wt8(float* p, float a, float b) { __hip_atomic_store((unsigned long long*)p, ((unsigned long long)__float_as_uint(b) << 32) | __float_as_uint(a), RLX_AGENT); }

template <class Epi, class Sched>
__device__ __forceinline__ void gemm_phase(LAS unsigned char* lds, const int wid, const int lda, const int ldb, const Sched& S, const Epi& E) {
    const int lane = lane_now(), tid = wid * 64 + lane, wr = wid >> 2, wc = wid & 3, fr = lane & 15, fq = lane >> 4;
    unsigned voffA[2], voffB[2];
#pragma unroll
    for (int i = 0; i < 2; ++i) { int R, C; stage_rc(tid * 16 + i * 8192, R, C); const int Rb = Epi::PERM ? ((R & ~31) + perm32(R & 31)) : R;
        voffA[i] = (unsigned)(R * lda + C) * 2u; voffB[i] = (unsigned)(Rb * ldb + C) * 2u; }
    const size_t kstep = (size_t)(BK * 2);
    const size_t hstepA_full = (size_t)HALF * lda * 2;
    const unsigned ldsw = (unsigned)wid * 1024u;
    const int aoff = lds_byte(wr * 64 + fr, fq * 8), boff = lds_byte(wc * 32 + fr, fq * 8);
#define PG8_SA(b, h) (((b) * 2 + (h)) * HTB)
#define PG8_SB(b, h) ((4 + (b) * 2 + (h)) * HTB)
#define PG8_STAGE(bufoff, gbase, voff) do { _Pragma("unroll") for (int _i = 0; _i < 2; ++_i) \
        __builtin_amdgcn_global_load_lds((const unsigned*)((const char*)(gbase) + (voff)[_i]), (LAS unsigned*)(lds + (bufoff) + ldsw + _i * 8192), 16, 0, 0); } while (0)
#define PG8_LDA(dst, b, h) do { _Pragma("unroll") for (int m = 0; m < 4; ++m) _Pragma("unroll") for (int k = 0; k < 2; ++k) dst[m][k] = *(const LAS bf16x8*)(lds + PG8_SA(b, h) + aoff + m * 2048 + k * 1024); } while (0)
#define PG8_LDB(dst, b, h) do { _Pragma("unroll") for (int n = 0; n < 2; ++n) _Pragma("unroll") for (int k = 0; k < 2; ++k) dst[n][k] = *(const LAS bf16x8*)(lds + PG8_SB(b, h) + boff + n * 2048 + k * 1024); } while (0)
#define PG8_MMA(ai, bj, At, Bt) do { __builtin_amdgcn_s_setprio(1); _Pragma("unroll") for (int m = 0; m < 4; ++m) _Pragma("unroll") for (int n = 0; n < 2; ++n) _Pragma("unroll") for (int k = 0; k < 2; ++k) \
        acc[ai][bj][m][n] = __builtin_amdgcn_mfma_f32_16x16x32_bf16(Bt[n][k], At[m][k], acc[ai][bj][m][n], 0, 0, 0); __builtin_amdgcn_s_setprio(0); } while (0)
#define PG8_WAIT_V(n) asm volatile("s_waitcnt vmcnt(" #n ")" ::: "memory")
#define PG8_WAIT_L(n) asm volatile("s_waitcnt lgkmcnt(" #n ")" ::: "memory")
#define PG8_BAR __builtin_amdgcn_s_barrier()
#define PG8_SCHED __builtin_amdgcn_sched_barrier(0)
    Unit cur, nxt; int ui = 0;
    if (!S.next(0, cur)) return;
    f32x4 acc[2][2][4][2];
#pragma unroll
    for (int a = 0; a < 2; ++a)
#pragma unroll
        for (int b = 0; b < 2; ++b)
#pragma unroll
            for (int m = 0; m < 4; ++m)
#pragma unroll
                for (int n = 0; n < 2; ++n) acc[a][b][m][n] = (f32x4){0.f, 0.f, 0.f, 0.f};
    bf16x8 At[4][2], B0[2][2], B1[2][2];
    const char* cA = S.a_ptr(cur) + (cur.half == 2 ? hstepA_full : 0); const char* cB0 = S.b_ptr(cur, 0); const char* cB1 = S.b_ptr(cur, 1);
    size_t hstepA = cur.half ? 0 : hstepA_full;
    PG8_STAGE(PG8_SB(0, 0), cB0, voffB); PG8_STAGE(PG8_SB(0, 1), cB1, voffB); PG8_STAGE(PG8_SA(0, 0), cA, voffA); PG8_STAGE(PG8_SA(0, 1), cA + hstepA, voffA);
    if (wr == 1) PG8_BAR;
    PG8_WAIT_V(2); PG8_BAR;
    PG8_STAGE(PG8_SB(1, 0), cB0 + kstep, voffB); PG8_STAGE(PG8_SA(1, 0), cA + kstep, voffA); PG8_STAGE(PG8_SB(1, 1), cB1 + kstep, voffB);
    PG8_WAIT_V(6); PG8_BAR;
    for (;;) {
        const bool has_next = S.next(ui + 1, nxt);
        const char* nA = has_next ? S.a_ptr(nxt) + (nxt.half == 2 ? hstepA_full : 0) : cA; const char* nB0 = has_next ? S.b_ptr(nxt, 0) : cB0; const char* nB1 = has_next ? S.b_ptr(nxt, 1) : cB1;
        const size_t nhs = has_next ? (nxt.half ? 0 : hstepA_full) : hstepA; const bool whole = (cur.half == 0), wholeN = (cur.nhalf == 0);
        const int nt = cur.nt;
        for (int t = 0; t < nt; t += 2) {
            const bool last = (t == nt - 2);
            const char* a1 = cA + (size_t)(t + 1) * kstep;
            const char* a2 = last ? nA : cA + (size_t)(t + 2) * kstep;
            const char* b20 = last ? nB0 : cB0 + (size_t)(t + 2) * kstep; const char* b21 = last ? nB1 : cB1 + (size_t)(t + 2) * kstep;
            const char* a3 = a2 + kstep; const char* b30 = b20 + kstep; const char* b31 = b21 + kstep;
            PG8_LDB(B0, 0, 0); PG8_LDB(B1, 0, 1); PG8_SCHED; PG8_LDA(At, 0, 0); PG8_STAGE(PG8_SA(1, 1), a1 + hstepA, voffA);
            PG8_WAIT_V(8); PG8_WAIT_L(0); PG8_BAR; PG8_MMA(0, 0, At, B0); if (wholeN) { PG8_MMA(0, 1, At, B1); } PG8_BAR; PG8_SCHED;
            PG8_LDA(At, 0, 1); PG8_STAGE(PG8_SB(0, 0), b20, voffB); PG8_STAGE(PG8_SB(0, 1), b21, voffB); PG8_STAGE(PG8_SA(0, 0), a2, voffA);
            PG8_WAIT_V(8); PG8_WAIT_L(0); PG8_BAR; if (whole) { PG8_MMA(1, 0, At, B0); if (wholeN) { PG8_MMA(1, 1, At, B1); } } PG8_BAR; PG8_SCHED;
            PG8_LDB(B0, 1, 0); PG8_LDB(B1, 1, 1); PG8_SCHED; PG8_LDA(At, 1, 0); PG8_STAGE(PG8_SA(0, 1), a2 + (last ? nhs : hstepA), voffA);
            PG8_WAIT_V(8); PG8_WAIT_L(0); PG8_BAR; PG8_MMA(0, 0, At, B0); if (wholeN) { PG8_MMA(0, 1, At, B1); } PG8_BAR; PG8_SCHED;
            PG8_LDA(At, 1, 1); PG8_STAGE(PG8_SB(1, 0), b30, voffB); PG8_STAGE(PG8_SB(1, 1), b31, voffB); PG8_STAGE(PG8_SA(1, 0), a3, voffA);
            PG8_WAIT_V(8); PG8_WAIT_L(0); PG8_BAR; if (whole) { PG8_MMA(1, 0, At, B0); if (wholeN) { PG8_MMA(1, 1, At, B1); } } PG8_BAR; PG8_SCHED;
        }
        if (wr == 0) PG8_BAR;
        E(acc, cur, wr, wc, wid);
        if (!has_next) break;
#pragma unroll
        for (int a = 0; a < 2; ++a)
#pragma unroll
            for (int b = 0; b < 2; ++b)
#pragma unroll
                for (int m = 0; m < 4; ++m)
#pragma unroll
                    for (int n = 0; n < 2; ++n) acc[a][b][m][n] = (f32x4){0.f, 0.f, 0.f, 0.f};
        cur = nxt; cA = nA; cB0 = nB0; cB1 = nB1; hstepA = nhs; ++ui;
        if (wr == 1) PG8_BAR;
    }
    PG8_WAIT_V(0);
    PG8_BAR;
#undef PG8_SA
#undef PG8_SB
#undef PG8_STAGE
#undef PG8_LDA
#undef PG8_LDB
#undef PG8_MMA
#undef PG8_WAIT_V
#undef PG8_WAIT_L
#undef PG8_BAR
#undef PG8_SCHED
}
}
struct Ptrs {
    const float *x_prompt, *x_sample, *cache_lat, *cache_krope, *state_gla, *cache_conv, *meta, *g_mix, *w_in, *w_a2, *b_a, *g_gla, *g_q, *w_uq, *g_kv, *w_uk, *w_uv, *w_o, *g_ffn, *w_up, *conv_w, *conv_b, *w_down, *final_norm;
    float* out; unsigned char* ws;
};
#define WSP(T, off) ((T*)(P.ws + (off)))

struct TileOrder {
    int nM, nN, nwg, G, c;
    __device__ __forceinline__ void init(int nM_, int nN_, int G_, int c_) { nM = nM_; nN = nN_; nwg = nM * nN; G = G_; c = c_; }
    __device__ __forceinline__ bool map(int i, int& pm, int& pn) const { return map_L((long)i * G + c, pm, pn); }
    __device__ __forceinline__ bool map_L(long L, int& pm, int& pn) const {
        if (L >= nwg) return false;
        int wgid = (int)L; { const int q = nwg / 8, r = nwg % 8, xcd = wgid % 8, off = wgid / 8; wgid = (xcd < r ? xcd * (q + 1) : r * (q + 1) + (xcd - r) * q) + off; }
        const int nig = 8 * nN, gid = wgid / nig, fm = gid * 8, gsz = (nM - fm) < 8 ? (nM - fm) : 8;
        pm = fm + ((wgid % nig) % gsz); pn = (wgid % nig) / gsz; return true;
    }
};
struct SchedPlain {
    TileOrder o; const char* A; const char* Bt; size_t a_tile, b_tile;
    int nt;
    int quarter = 0;
    __device__ __forceinline__ bool next(int i, pg8::Unit& u) const { u.kind = 0; u.nt = nt; u.part = 0; u.half = 0; u.nhalf = 0;
        const long L = (long)i * o.G + o.c; const long nfull = (long)(o.nwg / o.G) * o.G;
        if (L < nfull) return o.map_L(L, u.pm, u.pn);
        const long L2 = L - nfull;
        if (2 * (o.nwg - nfull) > o.G) return o.map_L(L, u.pm, u.pn);
        if (quarter) { u.half = 1 + (int)(L2 & 1); u.nhalf = 1 + (int)((L2 >> 1) & 1); return o.map_L(nfull + (L2 >> 2), u.pm, u.pn); }
        u.half = 1 + (int)(L2 & 1); return o.map_L(nfull + (L2 >> 1), u.pm, u.pn); }
    __device__ __forceinline__ const char* a_ptr(const pg8::Unit& u) const { return A + (size_t)u.pm * a_tile; }
    __device__ __forceinline__ const char* b_ptr(const pg8::Unit& u, int h) const { return Bt + (size_t)u.pn * b_tile + (size_t)(u.nhalf ? u.nhalf - 1 : h) * (b_tile >> 1); }
};
struct SchedSK {
    pg8::SkRange r; int nN; const char* A; const char* Bt; size_t a_tile, b_tile;
    __device__ __forceinline__ bool next(int i, pg8::Unit& u) const { int tile, kt0; u.half = 0; u.nhalf = 0; if (!pg8::sk_unit(r, i, tile, kt0, u.nt, u.part)) return false; u.pm = tile / nN; u.pn = tile - u.pm * nN; u.kind = kt0; return true; }
    __device__ __forceinline__ const char* a_ptr(const pg8::Unit& u) const { return A + (size_t)u.pm * a_tile + (size_t)u.kind * 128; }
    __device__ __forceinline__ const char* b_ptr(const pg8::Unit& u, int h) const { return Bt + (size_t)u.pn * b_tile + (size_t)h * (b_tile >> 1) + (size_t)u.kind * 128; }
};
template <int NS>
struct SchedSplitTail {
    TileOrder o; const char* A; const char* Bt; size_t a_tile, b_tile; int nt;
    __device__ __forceinline__ bool next(int i, pg8::Unit& u) const {
        u.half = 0; u.nhalf = 0; if (i == 0) { u.kind = 0; u.nt = nt; u.part = 0; return o.map(0, u.pm, u.pn); }
        if (i > 1) return false;
        const int t = o.G + o.c / NS; if (t >= o.nwg) return false;
        const int q = o.c % NS; TileOrder o2 = o; o2.c = t; o2.G = 0; o2.map(0, u.pm, u.pn); u.nt = nt / NS; u.kind = q * (nt / NS); u.part = 1 + q; return true;
    }
    __device__ __forceinline__ const char* a_ptr(const pg8::Unit& u) const { return A + (size_t)u.pm * a_tile + (size_t)u.kind * 128; }
    __device__ __forceinline__ const char* b_ptr(const pg8::Unit& u, int h) const { return Bt + (size_t)u.pn * b_tile + (size_t)h * (b_tile >> 1) + (size_t)u.kind * 128; }
};
struct SchedP2 {
    int G, c; const char* ws;
    __device__ __forceinline__ bool next(int i, pg8::Unit& u) const {
        int L = i * G + c; u.nt = 8; u.part = 0; u.half = 0; u.nhalf = 0;
        if (L < 420) { u.kind = 0; u.pm = L / 12; u.pn = L % 12; return true; } L -= 420;
        if (L < 528) { u.kind = 1; const int t = L >> 4; u.pm = t < 32 ? t : 34; u.pn = L & 15; return true; } L -= 528;
        if (L < 64) { u.kind = 2; u.pm = 32 + (L >> 5); u.pn = L & 31; return true; }
        return false;
    }
    __device__ __forceinline__ const char* a_ptr(const pg8::Unit& u) const { return ws + WS_H + ((size_t)u.pm * 256 * NH + (u.kind == 1 ? HC_CKV : HC_CQ)) * 2; }
    __device__ __forceinline__ const char* b_ptr(const pg8::Unit& u, int h) const { const size_t off = u.kind == 0 ? WS_WQT : (u.kind == 1 ? WS_WKVT : WS_WABS); return ws + off + ((size_t)u.pn * 256 + h * 128) * 512 * 2; }
};
struct SchedWabs {
    int G, c; const char* WUKN; const char* WUQN;
    __device__ __forceinline__ bool next(int i, pg8::Unit& u) const { const int L = i * G + c; if (L >= 64) return false; u.nt = 2; u.part = 0; u.half = 0; u.nhalf = 0; u.kind = 3 + (L >> 2); u.pm = (L >> 1) & 1; u.pn = L & 1; return true; }
    __device__ __forceinline__ const char* a_ptr(const pg8::Unit& u) const { return WUKN + ((size_t)u.pm * 256 * 2048 + (u.kind - 3) * 128) * 2; }
    __device__ __forceinline__ const char* b_ptr(const pg8::Unit& u, int h) const { return WUQN + (((size_t)u.pn * 256 + h * 128) * 3072 + (u.kind - 3) * 192) * 2; }
};

struct EpiInProj {
    static constexpr bool PERM = true;
    bf16_t* H; const float* rsx; float* ss;
    __device__ __forceinline__ void operator()(const pg8::Acc& acc, const pg8::Unit& u, int wr, int wc, int wid) const {
        const int lane_ = lane_now(), fr = lane_ & 15, fq = lane_ >> 4;
        const int row0 = u.pm * 256 + wr * 64 + fr + (u.half == 2 ? 128 : 0), col0 = u.pn * 256 + wc * 32 + 8 * fq;
        const bool stats = (u.pn >= 24 && u.pn < 28);
#pragma unroll
        for (int ai = 0; ai < 2; ++ai) if (ai == 0 || !u.half)
#pragma unroll
            for (int m = 0; m < 4; ++m) {
                const int row = row0 + ai * 128 + m * 16; const float rs = rsx[row]; float sq = 0.f;
#pragma unroll
                for (int bj = 0; bj < 2; ++bj) { const f32x4 v0 = acc[ai][bj][m][0] * rs, v1 = acc[ai][bj][m][1] * rs;
                    sq += (v0[0] * v0[0] + v0[1] * v0[1]) + (v0[2] * v0[2] + v0[3] * v0[3]) + (v1[0] * v1[0] + v1[1] * v1[1]) + (v1[2] * v1[2] + v1[3] * v1[3]);
                    u32x4 w; w.x = pk2(v0[0], v0[1]); w.y = pk2(v0[2], v0[3]); w.z = pk2(v1[0], v1[1]); w.w = pk2(v1[2], v1[3]);
                    *(u32x4*)(H + (size_t)row * NH + col0 + bj * 128) = w; }
                if (stats) { sq += __shfl_xor(sq, 16); sq += __shfl_xor(sq, 32); if (fq == 0) ss[row * 16 + (u.pn - 24) * 4 + wc] = sq; }
            }
    }
};
struct EpiP2 {
    static constexpr bool PERM = true;
    bf16_t *Q, *KV, *QLAT, *WABS; const float* ss; const f32x2* rope;
    __device__ __forceinline__ void operator()(const pg8::Acc& acc, const pg8::Unit& u, int wr, int wc, int wid) const {
        const int lane_ = lane_now(), fr = lane_ & 15, fq = lane_ >> 4;
        const int rl0 = wr * 64 + fr + (u.half == 2 ? 128 : 0), cl0 = wc * 32 + 8 * fq;
        bf16_t* dst; int ldc; int mode;
        if (u.kind == 0) { dst = Q + (size_t)u.pm * 256 * QP + u.pn * 256; ldc = QP; mode = 0; }
        else if (u.kind == 1) { dst = KV + (size_t)(u.pm < 32 ? u.pm : 32) * 256 * 4096 + u.pn * 256; ldc = 4096; mode = 1; }
        else if (u.kind == 2) { dst = QLAT + (size_t)(u.pm - 32) * 256 * 8192 + u.pn * 256; ldc = 8192; mode = 0; }
        else { dst = WABS + ((size_t)(u.kind - 3) * 512 + u.pm * 256) * 512 + u.pn * 256; ldc = 512; mode = 2; }
        const bool do_rope = (u.kind == 0 && u.pn >= 8);
#pragma unroll
        for (int ai = 0; ai < 2; ++ai) if (ai == 0 || !u.half)
#pragma unroll
            for (int m = 0; m < 4; ++m) {
                const int rl = rl0 + ai * 128 + m * 16, row = u.pm * 256 + rl; float sc = 1.f;
                if (mode != 2) { const f32x4* sp = (const f32x4*)(ss + row * 16 + (mode == 1 ? 8 : 0)); const f32x4 a = sp[0], b = sp[1];
                    sc = __builtin_amdgcn_rsqf(((a[0] + a[1]) + (a[2] + a[3]) + (b[0] + b[1]) + (b[2] + b[3])) * (1.f / 512.f) + EPS); if (mode == 0) sc *= QSCALE; }
#pragma unroll
                for (int bj = 0; bj < 2; ++bj) { f32x4 v0 = acc[ai][bj][m][0] * sc, v1 = acc[ai][bj][m][1] * sc;
                    if (do_rope) { const int i0 = ((u.pn * 256 + bj * 128 + cl0) & 63) >> 1; const f32x4* rp = (const f32x4*)(rope + (size_t)row * 32 + i0); const f32x4 c0 = rp[0], c1 = rp[1];
                        f32x4 t0, t1; t0[0] = v0[0] * c0[0] - v0[1] * c0[1]; t0[1] = v0[1] * c0[0] + v0[0] * c0[1]; t0[2] = v0[2] * c0[2] - v0[3] * c0[3]; t0[3] = v0[3] * c0[2] + v0[2] * c0[3];
                        t1[0] = v1[0] * c1[0] - v1[1] * c1[1]; t1[1] = v1[1] * c1[0] + v1[0] * c1[1]; t1[2] = v1[2] * c1[2] - v1[3] * c1[3]; t1[3] = v1[3] * c1[2] + v1[2] * c1[3]; v0 = t0; v1 = t1; }
                    u32x4 w; w.x = pk2(v0[0], v0[1]); w.y = pk2(v0[2], v0[3]); w.z = pk2(v1[0], v1[1]); w.w = pk2(v1[2], v1[3]);
                    *(u32x4*)(dst + (size_t)rl * ldc + bj * 128 + cl0) = w; }
            }
    }
};
struct EpiWabs {
    static constexpr bool PERM = true;
    bf16_t* WABS;
    __device__ __forceinline__ void operator()(const pg8::Acc& acc, const pg8::Unit& u, int wr, int wc, int wid) const {
        const int lane_ = lane_now(), fr = lane_ & 15, fq = lane_ >> 4;
        bf16_t* dst = WABS + ((size_t)(u.kind - 3) * 512 + u.pm * 256 + wr * 64 + fr) * 512 + u.pn * 256 + wc * 32 + 8 * fq;
#pragma unroll
        for (int ai = 0; ai < 2; ++ai) if (ai == 0 || !u.half)
#pragma unroll
            for (int m = 0; m < 4; ++m)
#pragma unroll
                for (int bj = 0; bj < 2; ++bj) { const f32x4 v0 = acc[ai][bj][m][0], v1 = acc[ai][bj][m][1];
                    u32x4 w; w.x = pk2(v0[0], v0[1]); w.y = pk2(v0[2], v0[3]); w.z = pk2(v1[0], v1[1]); w.w = pk2(v1[2], v1[3]);
                    *(u32x4*)(dst + (size_t)(ai * 128 + m * 16) * 512 + bj * 128) = w; }
    }
};
struct EpiOut {
    static constexpr bool PERM = false;
    const float *xp, *xs, *meta; float* dout; float* x2m; bf16_t* x2b; float* ss2; unsigned* flags;
    __device__ __forceinline__ void operator()(const pg8::Acc& acc, const pg8::Unit& u, int wr, int wc, int wid) const {
        const int lane_ = lane_now(), fr = lane_ & 15, fq = lane_ >> 4;
        const int rl0 = wr * 64 + fr + (u.half == 2 ? 128 : 0), c0 = u.pn * 256 + wc * 32 + 4 * fq;
        const float* xb = u.pm < 32 ? xp + (size_t)u.pm * 256 * DM : (u.pm < 34 ? xs + (size_t)(u.pm - 32) * 256 * DM : meta);
        float* ob = u.pm < 34 ? dout + (size_t)u.pm * 256 * DM : x2m;
        unsigned* flag = flags + u.pm * 8 + u.pn;
        if (u.part == 2) pg8::sk_wait(flag, wid);
#pragma unroll
        for (int ai = 0; ai < 2; ++ai) if (ai == 0 || !u.half)
#pragma unroll
            for (int m = 0; m < 4; ++m) {
                const int rl = rl0 + ai * 128 + m * 16, row = u.pm * 256 + rl; const bool xv = (u.pm < 34) || (rl < 16); float sq = 0.f;
#pragma unroll
                for (int bj = 0; bj < 2; ++bj)
#pragma unroll
                    for (int n = 0; n < 2; ++n) { const int c = c0 + bj * 128 + n * 16;
                        f32x4 xx = (f32x4){0.f, 0.f, 0.f, 0.f};
                        if (u.part == 2) xx = *(const f32x4*)(ob + (size_t)rl * DM + c); else if (xv) xx = *(const f32x4*)(xb + (size_t)rl * DM + c);
                        const f32x4 v = xx + acc[ai][bj][m][n];
                        if (u.part == 1) { *(f32x4*)(ob + (size_t)rl * DM + c) = v; }
                        else { sq += (v[0] * v[0] + v[1] * v[1]) + (v[2] * v[2] + v[3] * v[3]);
                            *(f32x4*)(ob + (size_t)rl * DM + c) = v;
                            u32x2 w; w.x = pk2(v[0], v[1]); w.y = pk2(v[2], v[3]); *(u32x2*)(x2b + (size_t)row * DM + c) = w; } }
                if (u.part != 1) { sq += __shfl_xor(sq, 16); sq += __shfl_xor(sq, 32); if (fq == 0) ss2[row * 32 + u.pn * 4 + wc] = sq; }
            }
        if (u.part == 1) pg8::sk_publish(flag);
    }
};
struct EpiUp {
    static constexpr bool PERM = true;
    bf16_t* U;
    __device__ __forceinline__ void operator()(const pg8::Acc& acc, const pg8::Unit& u, int wr, int wc, int wid) const {
        const int lane_ = lane_now(), fr = lane_ & 15, fq = lane_ >> 4;
        const int row0 = u.pm * 256 + wr * 64 + fr + (u.half == 2 ? 128 : 0), col0 = u.pn * 256 + wc * 32 + 8 * fq + (u.nhalf == 2 ? 128 : 0);
#pragma unroll
        for (int ai = 0; ai < 2; ++ai) if (ai == 0 || !u.half)
#pragma unroll
            for (int m = 0; m < 4; ++m) { const int row = row0 + ai * 128 + m * 16;
#pragma unroll
                for (int bj = 0; bj < 2; ++bj) if (bj == 0 || !u.nhalf) { const f32x4 v0 = acc[ai][bj][m][0], v1 = acc[ai][bj][m][1];
                    u32x4 w; w.x = pk2(v0[0], v0[1]); w.y = pk2(v0[2], v0[3]); w.z = pk2(v1[0], v1[1]); w.w = pk2(v1[2], v1[3]);
                    *(u32x4*)(U + (size_t)row * DFF2 + col0 + bj * 128) = w; } }
    }
};
struct EpiDown {
    static constexpr bool PERM = false; static constexpr int NS = 4;
    float* dout; unsigned* flags; LAS unsigned char* lds;
    __device__ __forceinline__ void operator()(const pg8::Acc& acc, const pg8::Unit& u, int wr, int wc, int wid) const {
        const int lane_ = lane_now(), fr = lane_ & 15, fq = lane_ >> 4;
        float* tb = dout + (size_t)u.pm * 256 * DM + u.pn * 256;
        if (u.part > 0) {
            asm volatile("s_waitcnt vmcnt(0)" ::: "memory"); __builtin_amdgcn_s_barrier(); asm volatile("" ::: "memory");
            LAS float* wl = (LAS float*)(lds + wid * 17408);
#pragma unroll
            for (int ai = 0; ai < 2; ++ai) {
#pragma unroll
                for (int m = 0; m < 4; ++m)
#pragma unroll
                    for (int bj = 0; bj < 2; ++bj)
#pragma unroll
                        for (int n = 0; n < 2; ++n) *(LAS f32x4*)(wl + (m * 16 + fr) * 68 + bj * 32 + n * 16 + 4 * fq) = acc[ai][bj][m][n];
                asm volatile("s_waitcnt lgkmcnt(0)" ::: "memory");
                float* gp = tb + (size_t)(ai * 128 + wr * 64) * DM + (lane_ < 32 ? wc * 32 + lane_ : 128 + wc * 32 + (lane_ - 32));
#pragma unroll 8
                for (int rr = 0; rr < 64; ++rr) atomicAdd(gp + (size_t)rr * DM, wl[rr * 68 + lane_]);
                asm volatile("s_waitcnt lgkmcnt(0)" ::: "memory"); }
            return; }
        const unsigned lo = (unsigned)((wr * 64 + fr + (u.half == 2 ? 128 : 0)) * DM + wc * 32 + 4 * fq + (u.nhalf == 2 ? 128 : 0)) * 4u;
#pragma unroll
        for (int ai = 0; ai < 2; ++ai) if (ai == 0 || !u.half)
#pragma unroll
            for (int m = 0; m < 4; ++m)
#pragma unroll
                for (int bj = 0; bj < 2; ++bj) if (bj == 0 || !u.nhalf)
#pragma unroll
                    for (int n = 0; n < 2; ++n) { const unsigned off = lo + (unsigned)((ai * 128 + m * 16) * DM + bj * 128 + n * 16) * 4u; *(f32x4*)((char*)tb + off) = *(const f32x4*)((const char*)tb + off) + acc[ai][bj][m][n]; }
    }
};
struct WaveCtx { LAS unsigned char* lds; int wave, gw, ngw; };

#define LDS_WAIT() asm volatile("s_waitcnt lgkmcnt(0)" ::: "memory")
constexpr int TR_P = 144;
template <class ColMap>
__device__ __forceinline__ void transpose_item(const float* __restrict__ W, int K, int Nsrc, const float* __restrict__ gain, bf16_t* __restrict__ WT, LAS unsigned char* scr, int item, int nblk, int lane, const ColMap& cm) {
    const int kb = item / nblk, nb = item - kb * nblk, k0 = 64 * kb, n0 = 64 * nb, kr = lane >> 4, n4 = (lane & 15) * 4;
    const int sc = cm(n0 + n4); const bool contig = (sc >= 0) && (cm(n0 + n4 + 3) == sc + 3);
    f32x4 v[16];
    if (contig) {
#pragma unroll
        for (int i = 0; i < 16; ++i) v[i] = *(const f32x4*)(W + (size_t)(k0 + kr + 4 * i) * Nsrc + sc);
    } else { const int s1 = cm(n0 + n4 + 1), s2 = cm(n0 + n4 + 2), s3 = cm(n0 + n4 + 3);
#pragma unroll
        for (int i = 0; i < 16; ++i) { const float* wr = W + (size_t)(k0 + kr + 4 * i) * Nsrc; v[i] = (f32x4){sc >= 0 ? wr[sc] : 0.f, s1 >= 0 ? wr[s1] : 0.f, s2 >= 0 ? wr[s2] : 0.f, s3 >= 0 ? wr[s3] : 0.f}; } }
#pragma unroll
    for (int i = 0; i < 16; ++i) { const float gk = gain ? gain[k0 + kr + 4 * i] : 1.f; u32x2 w; w.x = pk2(v[i][0] * gk, v[i][1] * gk); w.y = pk2(v[i][2] * gk, v[i][3] * gk);
        *(LAS u32x2*)(scr + (kr + 4 * i) * TR_P + n4 * 2) = w; }
    LDS_WAIT(); asm volatile("" ::: "memory");
    const int gi = lane >> 4, li = lane & 15; LAS const unsigned char* rb = scr + (li >> 2) * TR_P + (16 * gi + 4 * (li & 3)) * 2;
    bf16_t* wo = WT + (size_t)(n0 + 16 * gi + li) * K + k0;
#pragma unroll
    for (int c = 0; c < 8; ++c) { const s16x4 lo = lds_tr(rb + (8 * c) * TR_P), hi = lds_tr(rb + (8 * c + 4) * TR_P); *(bf16x8*)(wo + 8 * c) = cat8(lo, hi); }
    LDS_WAIT(); asm volatile("" ::: "memory");
}
struct MapIn {
    __device__ __forceinline__ int operator()(int n) const {
        if (n < 6144) return n;
        if (n < 6656) return 6160 + (n - 6144);
        if (n < 7168) return 6672 + (n - 6656);
        if (n < 9216) return 7248 + (n - 7168);
        if (n < 11264) return 9296 + (n - 9216);
        if (n < 11328) { const int j = n - 11264, i = j >> 1; return 7184 + ((j & 1) ? i + 32 : i); }
        if (n < 11344) return 6144 + (n - 11328);
        return -1; }
};
struct MapQ {
    __device__ __forceinline__ int operator()(int n) const {
        if (n < 2048) return (n >> 7) * 192 + (n & 127);
        const int j = n - 2048, h = j >> 6, jj = j & 63, i = jj >> 1; return h * 192 + 128 + ((jj & 1) ? i + 32 : i); }
};
struct MapId { __device__ __forceinline__ int operator()(int n) const { return n; } };
struct MapOff { int off; __device__ __forceinline__ int operator()(int n) const { return n - off; } };

__device__ __forceinline__ void unpack8bf(const u32x4 w, float (&v)[8]) { v[0] = bflo(w.x); v[1] = bfhi(w.x); v[2] = bflo(w.y); v[3] = bfhi(w.y); v[4] = bflo(w.z); v[5] = bfhi(w.z); v[6] = bflo(w.w); v[7] = bfhi(w.w); }
__device__ __forceinline__ void load8bf(const bf16_t* p, float (&v)[8]) { const u32x4 w = *(const u32x4*)p; v[0] = bflo(w.x); v[1] = bfhi(w.x); v[2] = bflo(w.y); v[3] = bfhi(w.y); v[4] = bflo(w.z); v[5] = bfhi(w.z); v[6] = bflo(w.w); v[7] = bfhi(w.w); }
__device__ __forceinline__ u32x4 pack8(const float (&v)[8]) { u32x4 w; w.x = pk2(v[0], v[1]); w.y = pk2(v[2], v[3]); w.z = pk2(v[4], v[5]); w.w = pk2(v[6], v[7]); return w; }

__device__ __forceinline__ void p0_prologue(const Ptrs& P, const WaveCtx& C) {
    const int lane = lane_now();
    LAS unsigned char* scr = C.lds + C.wave * 16384;
    constexpr int I_IN = 32 * 180, I_Q = 8 * 48, I_KV = 8 * 32, I_O = 32 * 32, I_UV = 8 * 32;
    constexpr int NITEMS = I_IN + I_Q + 2 * I_KV + I_O + I_UV;
#ifdef PROBE_P0A
    const unsigned long long tp0_ = __builtin_amdgcn_s_memrealtime();
#endif
    for (int it = C.gw; it < NITEMS; it += C.ngw) {
        int r = it;
        if (r < I_IN) { transpose_item(P.w_in, DM, IN_COLS, P.g_mix, WSP(bf16_t, WS_W1T), scr, r, 180, lane, MapIn()); continue; } r -= I_IN;
        if (r < I_Q) { transpose_item(P.w_uq, 512, 3072, P.g_q, WSP(bf16_t, WS_WQT), scr, r, 48, lane, MapQ()); continue; } r -= I_Q;
        if (r < I_KV) { transpose_item(P.w_uk, 512, 2048, P.g_kv, WSP(bf16_t, WS_WKVT), scr, r, 32, lane, MapId()); continue; } r -= I_KV;
        if (r < I_KV) { transpose_item(P.w_uv, 512, 2048, P.g_kv, WSP(bf16_t, WS_WKVT) + (size_t)2048 * 512, scr, r, 32, lane, MapId()); continue; } r -= I_KV;
        if (r < I_O) { transpose_item(P.w_o, DM, DM, nullptr, WSP(bf16_t, WS_WOT), scr, r, 32, lane, MapId()); continue; } r -= I_O;
        transpose_item(P.w_uv, 512, 2048, nullptr, WSP(bf16_t, WS_WUVT), scr, r, 32, lane, MapId());
    }
    { const int nth = C.ngw * 64, t0 = C.gw * 64 + lane;
      for (int i = t0; i < 512 * 2048 / 4; i += nth) { const f32x4 v = *(const f32x4*)(P.w_uk + (size_t)i * 4); u32x2 w; w.x = pk2(v[0], v[1]); w.y = pk2(v[2], v[3]); *(u32x2*)(WSP(bf16_t, WS_WUKN) + (size_t)i * 4) = w; }
      for (int i = t0; i < 512 * 3072 / 4; i += nth) { const f32x4 v = *(const f32x4*)(P.w_uq + (size_t)i * 4) * P.g_q[(i * 4) / 3072]; u32x2 w; w.x = pk2(v[0], v[1]); w.y = pk2(v[2], v[3]); *(u32x2*)(WSP(bf16_t, WS_WUQN) + (size_t)i * 4) = w; } }
#ifdef PROBE_P0A
    { const unsigned long long tp1_ = __builtin_amdgcn_s_memrealtime(); while (__builtin_amdgcn_s_memrealtime() - tp1_ < tp1_ - tp0_) __builtin_amdgcn_s_sleep(8); }
#endif
#ifdef PROBE_P0B
    const unsigned long long tq0_ = __builtin_amdgcn_s_memrealtime();
#endif
    for (int rowa = C.gw; rowa < M_PAD; rowa += 2 * C.ngw) { const int rowb = rowa + C.ngw; const bool two = rowb < M_PAD;
        const float* srca = rowa < R_SAMPLE ? P.x_prompt + (size_t)rowa * DM : (rowa < R_META ? P.x_sample + (size_t)(rowa - R_SAMPLE) * DM : (rowa < M_REAL ? P.meta + (size_t)(rowa - R_META) * DM : nullptr));
        const float* srcb = !two ? nullptr : rowb < R_SAMPLE ? P.x_prompt + (size_t)rowb * DM : (rowb < R_META ? P.x_sample + (size_t)(rowb - R_SAMPLE) * DM : (rowb < M_REAL ? P.meta + (size_t)(rowb - R_META) * DM : nullptr));
        f32x4 xa[8], xb[8];
#pragma unroll
        for (int j = 0; j < 8; ++j) { xa[j] = (f32x4){0.f, 0.f, 0.f, 0.f}; xb[j] = xa[j]; }
        if (srca) {
#pragma unroll
            for (int j = 0; j < 8; ++j) xa[j] = *(const f32x4*)(srca + (j * 64 + lane) * 4); }
        if (srcb) {
#pragma unroll
            for (int j = 0; j < 8; ++j) xb[j] = *(const f32x4*)(srcb + (j * 64 + lane) * 4); }
#pragma unroll
        for (int hh = 0; hh < 2; ++hh) { if (hh == 1 && !two) continue;
            const int row = hh ? rowb : rowa; const bool real = hh ? (srcb != nullptr) : (srca != nullptr);
            bf16_t* dst = WSP(bf16_t, WS_XBF) + (size_t)row * DM; float s = 0.f;
#pragma unroll
            for (int j = 0; j < 8; ++j) { const f32x4 v = hh ? xb[j] : xa[j]; s += (v[0] * v[0] + v[1] * v[1]) + (v[2] * v[2] + v[3] * v[3]); }
            s = wave_sum(s);
#pragma unroll
            for (int j = 0; j < 8; ++j) { const f32x4 v = hh ? xb[j] : xa[j]; u32x2 w; w.x = pk2(v[0], v[1]); w.y = pk2(v[2], v[3]); *(u32x2*)(dst + (j * 64 + lane) * 4) = w; }
            if (lane == 0) WSP(float, WS_RSX)[row] = real ? __builtin_amdgcn_rsqf(s * (1.f / DM) + EPS) : 0.f;
            if (lane < 32) { const int pos = row < R_SAMPLE ? row + N_META : (row < R_META ? PAST + ((row - R_SAMPLE) & 15) : (row < M_REAL ? row - R_META : 0));
                double inv = 1.0; for (int k = 0; k < lane; ++k) inv *= 0.74989420933245582730;
                const double ang = (double)pos * inv, qd = __builtin_rint(ang * 0.63661977236758134308), r = (ang - qd * 1.57079632679489655800) - qd * 6.12323399573676603587e-17, r2 = r * r;
                const double sn = r * (1.0 + r2 * (-1.0 / 6 + r2 * (1.0 / 120 + r2 * (-1.0 / 5040 + r2 * (1.0 / 362880 + r2 * (-1.0 / 39916800 + r2 * (1.0 / 6227020800.0)))))));
                const double cs = 1.0 + r2 * (-0.5 + r2 * (1.0 / 24 + r2 * (-1.0 / 720 + r2 * (1.0 / 40320 + r2 * (-1.0 / 3628800 + r2 * (1.0 / 479001600.0 + r2 * (-1.0 / 87178291200.0)))))));
                const int qi = ((int)qd) & 3; const double sv = (qi == 0) ? sn : (qi == 1) ? cs : (qi == 2) ? -sn : -cs, cv = (qi == 0) ? cs : (qi == 1) ? -sn : (qi == 2) ? -cs : sn;
                WSP(f32x2, WS_ROPE)[(size_t)row * 32 + lane] = (f32x2){(float)cv, (float)sv}; } }
    }
#ifdef PROBE_P0B
    { const unsigned long long tq1_ = __builtin_amdgcn_s_memrealtime(); while (__builtin_amdgcn_s_memrealtime() - tq1_ < tq1_ - tq0_) __builtin_amdgcn_s_sleep(8); }
#endif
}

__device__ __forceinline__ void p1_wabs(const Ptrs& P, const WaveCtx& C) {
    const int lane = lane_now(), r32 = lane & 31, hi = lane >> 5;
    const bf16_t* A = WSP(bf16_t, WS_WUKN); const bf16_t* B = WSP(bf16_t, WS_WUQN); bf16_t* W = WSP(bf16_t, WS_WABS);
    for (int it = C.gw; it < 4096; it += C.ngw) { const int h = it >> 8, jb = (it >> 4) & 15, kb = it & 15;
        const bf16_t* ap = A + (size_t)(32 * jb + r32) * 2048 + h * 128 + 8 * hi; const bf16_t* bp = B + (size_t)(32 * kb + r32) * 3072 + h * 192 + 8 * hi;
        f32x16 c = (f32x16){0.f, 0.f, 0.f, 0.f, 0.f, 0.f, 0.f, 0.f, 0.f, 0.f, 0.f, 0.f, 0.f, 0.f, 0.f, 0.f};
#pragma unroll
        for (int ks = 0; ks < 8; ++ks) c = MFMA32(*(const bf16x8*)(ap + 16 * ks), *(const bf16x8*)(bp + 16 * ks), c);
        bf16_t* wp = W + ((size_t)h * 512 + 32 * jb + 4 * hi) * 512 + 32 * kb + r32;
#pragma unroll
        for (int r = 0; r < 16; ++r) wp[(size_t)((r & 3) + 8 * (r >> 2)) * 512] = f2bf(c[r]); }
}

constexpr int I_CACHE = DEC_B * PAST / 4;
__device__ __forceinline__ void cache_conv_item(const Ptrs& P, int item, int lane) {
    f32x4 a[4], bb[4]; float k1[4], k2[4];
#pragma unroll
    for (int q = 0; q < 4; ++q) { const int it = item * 4 + q; const float* ls = P.cache_lat + (size_t)it * 512 + 8 * lane; a[q] = *(const f32x4*)ls; bb[q] = *(const f32x4*)(ls + 4);
        if (lane < 32) { const float* ks = P.cache_krope + (size_t)it * 64; k1[q] = ks[lane]; k2[q] = ks[lane + 32]; } }
#pragma unroll
    for (int q = 0; q < 4; ++q) { const int it = item * 4 + q; const int b = it >> 10, p = it & 1023;
        u32x4 w; w.x = pk2(a[q][0], a[q][1]); w.y = pk2(a[q][2], a[q][3]); w.z = pk2(bb[q][0], bb[q][1]); w.w = pk2(bb[q][2], bb[q][3]);
        *(u32x4*)(WSP(bf16_t, WS_SKL) + ((size_t)b * TK_S + p) * 512 + 8 * lane) = w;
        if (lane < 32) *(unsigned*)(WSP(bf16_t, WS_SKP) + ((size_t)b * TK_S + p) * 64 + 2 * lane) = pk2(k1[q], k2[q]); }
}

__device__ __forceinline__ float log_alpha(const float (&wa)[16], float ba, const bf16_t* ag) {
    float a[8], b[8]; load8bf(ag, a); load8bf(ag + 8, b); float z = ba;
#pragma unroll
    for (int k = 0; k < 8; ++k) z = fmaf(a[k], wa[k], z);
#pragma unroll
    for (int k = 0; k < 8; ++k) z = fmaf(b[k], wa[8 + k], z);
    const float ls = fminf(z, 0.f) - log1pf(__expf(-fabsf(z)));
    return fmaxf(ls * (1.f / 16.f), -5.f);
}
__device__ __forceinline__ void p2_rows(const Ptrs& P, const WaveCtx& C) {
    const int lane = lane_now();
    bf16_t* H = WSP(bf16_t, WS_H);
    const int nx_ = (137 * 16 > C.ngw && 137 * 16 - C.ngw < C.ngw) ? 137 * 16 - C.ngw : 0;
    auto rows_a = [&]() __attribute__((always_inline)) {
    for (int row = C.gw - nx_; row < M_REAL; row += C.ngw - nx_) { if (row < 0) break;
        const int srow = row - R_SAMPLE; const bool is_s = (row >= R_SAMPLE && row < R_META);
        const int opos = row < R_SAMPLE ? row + N_META : (is_s ? srow : row - R_META);
        float c[8]; load8bf(H + (size_t)row * NH + HC_CKV + 8 * lane, c); float s = 0.f;
#pragma unroll
        for (int j = 0; j < 8; ++j) s += c[j] * c[j];
        const float rs = __builtin_amdgcn_rsqf(wave_sum(s) * (1.f / 512.f) + EPS);
        const f32x4 g0 = *(const f32x4*)(P.g_kv + 8 * lane), g1 = *(const f32x4*)(P.g_kv + 8 * lane + 4);
        float l[8];
#pragma unroll
        for (int j = 0; j < 8; ++j) l[j] = c[j] * rs * (j < 4 ? g0[j] : g1[j - 4]);
        float* lo = P.out + (is_s ? O_LATS : O_LATP) + (size_t)opos * 512 + 8 * lane;
        *(f32x4*)lo = (f32x4){l[0], l[1], l[2], l[3]}; *(f32x4*)(lo + 4) = (f32x4){l[4], l[5], l[6], l[7]};
        if (is_s) *(u32x4*)(WSP(bf16_t, WS_SKL) + ((size_t)(srow >> 4) * TK_S + PAST + (srow & 15)) * 512 + 8 * lane) = pack8(l);
        if (lane < 32) { const unsigned w = *(const unsigned*)(H + (size_t)row * NH + HC_KPE + 2 * lane); const float x1 = bflo(w), x2 = bfhi(w);
            const f32x2 cs = WSP(f32x2, WS_ROPE)[(size_t)row * 32 + lane]; const float o1 = x1 * cs.x - x2 * cs.y, o2 = x2 * cs.x + x1 * cs.y;
            float* ko = P.out + (is_s ? O_KRS : O_KRP) + (size_t)opos * 64; ko[lane] = o1; ko[lane + 32] = o2;
            const unsigned pw = pk2(o1, o2); *(unsigned*)(WSP(bf16_t, WS_KPE) + (size_t)row * 64 + 2 * lane) = pw;
            if (is_s) *(unsigned*)(WSP(bf16_t, WS_SKP) + ((size_t)(srow >> 4) * TK_S + PAST + (srow & 15)) * 64 + 2 * lane) = pw; }
    }
    };
    bool rows_done = false;
    LAS float* las = (LAS float*)(C.lds + C.wave * 16384);
    for (int it = C.gw; it < 137 * 16; it += C.ngw) { const int j = it >> 4, cb = it & 15, col = cb * 64 + lane, h = cb >> 2, dk = col & 255; const bool is_s = (j >= 128 && j < 136);
        float wa[16];
#pragma unroll
        for (int k = 0; k < 16; ++k) wa[k] = P.w_a2[k * 1024 + col];
        const float ba = P.b_a[col]; const int row0 = 64 * j;
        const u32x4 ag0 = *(const u32x4*)(H + (size_t)(row0 + lane) * NH + HC_AG), ag1 = *(const u32x4*)(H + (size_t)(row0 + lane) * NH + HC_AG + 8);
        const bf16_t* hcl = H + (size_t)row0 * NH + col;
        float qv[4][16], kv[4][16];
#define P2_LD(buf, sb) do { _Pragma("unroll") for (int rr = 0; rr < 16; ++rr) { const bf16_t* hp = hcl + (size_t)((sb) * 16 + rr) * NH; qv[buf][rr] = bf1(hp[HC_Q]); kv[buf][rr] = bf1(hp[HC_K]); } } while (0)
        P2_LD(0, 0); P2_LD(1, 1); P2_LD(2, 2); P2_LD(3, 3);
        if (!rows_done) { rows_a(); rows_done = true; }
        float bl[4];
#pragma unroll
        for (int sub = 0; sub < 4; ++sub) { float s = 0.f;
            for (int r = 16 * sub; r < 16 * sub + 16; ++r) {
                const unsigned a0 = __builtin_amdgcn_readlane(ag0.x, r), a1 = __builtin_amdgcn_readlane(ag0.y, r), a2 = __builtin_amdgcn_readlane(ag0.z, r), a3 = __builtin_amdgcn_readlane(ag0.w, r);
                const unsigned a4 = __builtin_amdgcn_readlane(ag1.x, r), a5 = __builtin_amdgcn_readlane(ag1.y, r), a6 = __builtin_amdgcn_readlane(ag1.z, r), a7 = __builtin_amdgcn_readlane(ag1.w, r);
                float z = ba;
                z = fmaf(bflo(a0), wa[0], z); z = fmaf(bfhi(a0), wa[1], z); z = fmaf(bflo(a1), wa[2], z); z = fmaf(bfhi(a1), wa[3], z); z = fmaf(bflo(a2), wa[4], z); z = fmaf(bfhi(a2), wa[5], z); z = fmaf(bflo(a3), wa[6], z); z = fmaf(bfhi(a3), wa[7], z);
                z = fmaf(bflo(a4), wa[8], z); z = fmaf(bfhi(a4), wa[9], z); z = fmaf(bflo(a5), wa[10], z); z = fmaf(bfhi(a5), wa[11], z); z = fmaf(bflo(a6), wa[12], z); z = fmaf(bfhi(a6), wa[13], z); z = fmaf(bflo(a7), wa[14], z); z = fmaf(bfhi(a7), wa[15], z);
                float la = fmaxf((fminf(z, 0.f) - __logf(1.f + __expf(-fabsf(z)))) * (1.f / 16.f), -5.f);
                if (row0 + r >= M_REAL) la = 0.f;
                las[r * 64 + lane] = la; s += la; }
            bl[sub] = s; }
        if (!is_s) { const float t = (bl[0] + bl[1]) + (bl[2] + bl[3]); bl[0] = bl[1] = bl[2] = bl[3] = t; WSP(float, WS_DECP)[j * 1024 + col] = __expf(t); }
        else {
#pragma unroll
            for (int sub = 0; sub < 4; ++sub) WSP(float, WS_DECS)[(4 * (j - 128) + sub) * 1024 + col] = __expf(bl[sub]); }
        float bc = 0.f; bf16_t* ket = WSP(bf16_t, WS_KET) + ((size_t)(j * 4 + h) * 256 + dk) * 64; bf16_t* hc = H + (size_t)row0 * NH + col;
        const int d5 = col & 31, pofs = (8 * ((d5 >> 2) & 3) + 4 * (d5 >> 4) + (d5 & 3)) - d5;
#pragma unroll
        for (int sub = 0; sub < 4; ++sub) { const float blast = bl[sub]; if (is_s) bc = 0.f;
#pragma unroll
            for (int r8 = 0; r8 < 2; ++r8) { float ke[8];
#pragma unroll
                for (int rr = 0; rr < 8; ++rr) { const int r = sub * 16 + r8 * 8 + rr; bf16_t* hp = hc + (size_t)r * NH; bc += las[r * 64 + lane]; const float q = qv[sub][r8 * 8 + rr], k = kv[sub][r8 * 8 + rr];
                    hp[HC_Q + pofs] = f2bf(q * __expf(bc) * (1.f / 16.f)); hp[HC_K + pofs] = f2bf(k * __expf(-bc)); ke[rr] = k * __expf(blast - bc); }
                *(u32x4*)(ket + (sub * 2 + r8) * 8) = pack8(ke); } }
#undef P2_LD
    }
    if (!rows_done) rows_a();
}

constexpr int MG_QP = 528, MG_VP = 1040, MG_AP = 144;
constexpr int MG_QD = 0, MG_KI = 64 * MG_QP, MG_V = 2 * 64 * MG_QP, MG_ATT = MG_V + 64 * MG_VP, MG_SSQ = MG_ATT + 64 * MG_AP, MG_END = MG_SSQ + 2048, MG_OT = 0;
static_assert(MG_END <= MISC_OFF && 64 * MG_VP <= MG_V, "merge LDS");
__device__ __forceinline__ void p4_unit(const Ptrs& P, LAS unsigned char* lds, const int wid, int j, int h) {
    const int lane = lane_now(), tid = wid * 64 + lane, l15 = lane & 15, g = lane >> 4;
    const bf16_t* H = WSP(bf16_t, WS_H); const int row0 = 64 * j; const bool is_s = (j >= 128 && j < 136);
    { const char* hb = (const char*)(H + (size_t)row0 * NH + h * 256); const unsigned oq = (unsigned)((tid >> 5) * NH + (tid & 31) * 8) * 2u;
      u32x4 a[4], k[4];
#pragma unroll
      for (int i = 0; i < 4; ++i) { a[i] = *(const u32x4*)(hb + HC_Q * 2 + (oq + (unsigned)i * (16u * NH * 2u))); k[i] = *(const u32x4*)(hb + HC_K * 2 + (oq + (unsigned)i * (16u * NH * 2u))); }
      const char* vb = (const char*)(H + (size_t)row0 * NH + HC_V + h * 512); const unsigned ov = (unsigned)((tid >> 6) * NH + (tid & 63) * 8) * 2u;
      u32x4 v[8];
#pragma unroll
      for (int i = 0; i < 8; ++i) v[i] = *(const u32x4*)(vb + (ov + (unsigned)i * (8u * NH * 2u)));
#pragma unroll
      for (int i = 0; i < 4; ++i) { const int idx = tid + i * 512, r = idx >> 5, c = idx & 31; *(LAS u32x4*)(lds + MG_QD + r * MG_QP + c * 16) = a[i]; *(LAS u32x4*)(lds + MG_KI + r * MG_QP + c * 16) = k[i]; }
#pragma unroll
      for (int i = 0; i < 8; ++i) { const int idx = tid + i * 512, r = idx >> 6, c = idx & 63; *(LAS u32x4*)(lds + MG_V + r * MG_VP + c * 16) = v[i]; } }
    u32x2 ogr[4][4];
    { const bf16_t* og = WSP(bf16_t, WS_OG) + (size_t)(row0 + l15) * DM + h * 512 + 64 * wid + 4 * g;
#pragma unroll
      for (int ct = 0; ct < 4; ++ct)
#pragma unroll
        for (int dt = 0; dt < 4; ++dt) ogr[ct][dt] = *(const u32x2*)(og + (size_t)(16 * ct) * DM + 16 * dt); }
    u32x4 pre[4][4];
    { const bf16_t* Qp = WSP(bf16_t, WS_Q);
#pragma unroll
      for (int i = 0; i < 4; ++i) { const int idx = tid + i * 512, r = idx >> 6, cc = (idx & 63) * 8; const bf16_t* hp = H + (size_t)(row0 + r) * NH + h * 512 + cc;
        pre[i][0] = *(const u32x4*)(hp + HC_R); pre[i][1] = *(const u32x4*)(hp + HC_GA); pre[i][2] = *(const u32x4*)(hp + HC_GB); pre[i][3] = *(const u32x4*)(Qp + (size_t)(row0 + r) * QP + h * 512 + cc); } }
    __syncthreads();
#pragma unroll
    for (int k2 = 0; k2 < 2; ++k2) { const int tt = 2 * wid + k2, st = tt >> 2, ct = tt & 3; f32x4 a = (f32x4){0.f, 0.f, 0.f, 0.f};
        if (is_s ? st == ct : st <= ct) {
#pragma unroll
            for (int ks = 0; ks < 8; ++ks) { const bf16x8 af = *(LAS const bf16x8*)(lds + MG_KI + (16 * st + l15) * MG_QP + (ks * 32 + 8 * g) * 2), bf = *(LAS const bf16x8*)(lds + MG_QD + (16 * ct + l15) * MG_QP + (ks * 32 + 8 * g) * 2);
                a = MFMA16(af, bf, a); }
            if (st == ct) {
#pragma unroll
                for (int r = 0; r < 4; ++r) if (4 * g + r > l15) a[r] = 0.f; } }
        u32x2 w; w.x = pk2(a[0], a[1]); w.y = pk2(a[2], a[3]); *(LAS u32x2*)(lds + MG_ATT + (16 * ct + l15) * MG_AP + (16 * st + 4 * g) * 2) = w; }
    __syncthreads();
    f32x4 o[4][4];
#pragma unroll
    for (int dt = 0; dt < 4; ++dt)
#pragma unroll
        for (int ct = 0; ct < 4; ++ct) o[dt][ct] = (f32x4){0.f, 0.f, 0.f, 0.f};
#pragma unroll
    for (int k2 = 0; k2 < 2; ++k2) { bf16x8 bf[4];
#pragma unroll
        for (int ct = 0; ct < 4; ++ct) bf[ct] = *(LAS const bf16x8*)(lds + MG_ATT + (16 * ct + l15) * MG_AP + (32 * k2 + 8 * g) * 2);
#pragma unroll
        for (int dt = 0; dt < 4; ++dt) { LAS const unsigned char* vp = lds + MG_V + (32 * k2 + 8 * g + (l15 >> 2)) * MG_VP + (64 * wid + 16 * dt + 4 * (l15 & 3)) * 2; const bf16x8 vf = cat8(lds_tr(vp), lds_tr(vp + 4 * MG_VP));
#pragma unroll
            for (int ct = 0; ct < 4; ++ct) { if (32 * k2 > 16 * ct + 15) continue; o[dt][ct] = MFMA16(vf, bf[ct], o[dt][ct]); } } }
    {
#pragma unroll
      for (int ct = 0; ct < 4; ++ct) { float sq = 0.f;
#pragma unroll
        for (int dt = 0; dt < 4; ++dt) { const u32x2 w = ogr[ct][dt]; o[dt][ct][0] += bflo(w.x); o[dt][ct][1] += bfhi(w.x); o[dt][ct][2] += bflo(w.y); o[dt][ct][3] += bfhi(w.y);
            sq += (o[dt][ct][0] * o[dt][ct][0] + o[dt][ct][1] * o[dt][ct][1]) + (o[dt][ct][2] * o[dt][ct][2] + o[dt][ct][3] * o[dt][ct][3]); }
        sq += __shfl_xor(sq, 16); sq += __shfl_xor(sq, 32);
        if (g == 0) *(LAS float*)(lds + MG_SSQ + ((16 * ct + l15) * 8 + wid) * 4) = sq; } }
    __syncthreads();
#pragma unroll
    for (int ct = 0; ct < 4; ++ct) { const f32x4 s0 = *(LAS const f32x4*)(lds + MG_SSQ + (16 * ct + l15) * 32), s1 = *(LAS const f32x4*)(lds + MG_SSQ + (16 * ct + l15) * 32 + 16);
        const float rs = __builtin_amdgcn_rsqf(((s0[0] + s0[1]) + (s0[2] + s0[3]) + (s1[0] + s1[1]) + (s1[2] + s1[3])) * (1.f / 512.f) + EPS);
#pragma unroll
        for (int dt = 0; dt < 4; ++dt) { u32x2 w; w.x = pk2(o[dt][ct][0] * rs, o[dt][ct][1] * rs); w.y = pk2(o[dt][ct][2] * rs, o[dt][ct][3] * rs);
            *(LAS u32x2*)(lds + MG_OT + (16 * ct + l15) * MG_VP + (64 * wid + 16 * dt + 4 * g) * 2) = w; } }
    __syncthreads();
    { const bf16_t* Q = WSP(bf16_t, WS_Q); bf16_t* MG = WSP(bf16_t, WS_MERGED);
#pragma unroll
      for (int i = 0; i < 8; ++i) { const int idx = tid + i * 512, r = idx >> 6, cc = (idx & 63) * 8; const bf16_t* hp = H + (size_t)(row0 + r) * NH + h * 512 + cc;
        float on[8], rr[8], ga[8], gb[8], om[8], ov[8];
        { const u32x4 w = *(LAS const u32x4*)(lds + MG_OT + r * MG_VP + cc * 2); on[0] = bflo(w.x); on[1] = bfhi(w.x); on[2] = bflo(w.y); on[3] = bfhi(w.y); on[4] = bflo(w.z); on[5] = bfhi(w.z); on[6] = bflo(w.w); on[7] = bfhi(w.w); }
        if (i < 4) { unpack8bf(pre[i & 3][0], rr); unpack8bf(pre[i & 3][1], ga); unpack8bf(pre[i & 3][2], gb); unpack8bf(pre[i & 3][3], om); }
        else { load8bf(hp + HC_R, rr); load8bf(hp + HC_GA, ga); load8bf(hp + HC_GB, gb); load8bf(Q + (size_t)(row0 + r) * QP + h * 512 + cc, om); }
        const f32x4 g0 = *(const f32x4*)(P.g_gla + cc), g1 = *(const f32x4*)(P.g_gla + cc + 4);
#pragma unroll
        for (int q = 0; q < 8; ++q) ov[q] = sigmoidf_(ga[q]) * (on[q] * (q < 4 ? g0[q] : g1[q - 4])) * (rr[q] * sigmoidf_(rr[q])) + sigmoidf_(gb[q]) * om[q];
        *(u32x4*)(MG + (size_t)(row0 + r) * DM + h * 512 + cc) = pack8(ov); } }
    __syncthreads();
}

constexpr int I_UP = 32 * 176, I_DN = 88 * 32, I_FFN = I_UP + I_DN;
__device__ __forceinline__ void ffn_wconv_item(const Ptrs& P, LAS unsigned char* scr, int it, int lane) {
    if (it < I_UP) transpose_item(P.w_up, DM, DFF2, P.g_ffn, WSP(bf16_t, WS_WUPT), scr, it, 176, lane, MapId());
    else transpose_item(P.w_down, DFF, DM, nullptr, WSP(bf16_t, WS_WDT), scr, it - I_UP, 32, lane, MapId());
}

constexpr int I_SKU = DFF2 / 64;
__device__ __forceinline__ void skinny_up_item(const Ptrs& P, int item, int lane) {
    const int l15 = lane & 15, g = lane >> 4, n0 = 64 * item;
    const bf16_t* ap = WSP(bf16_t, WS_X2B) + (size_t)(R_META + l15) * DM + 8 * g; const bf16_t* bp = WSP(bf16_t, WS_WUPT) + (size_t)(n0 + l15) * DM + 8 * g;
    f32x4 acc[4]; for (int t = 0; t < 4; ++t) acc[t] = (f32x4){0.f, 0.f, 0.f, 0.f};
#pragma unroll 4
    for (int ks = 0; ks < DM / 32; ++ks) { const bf16x8 a = *(const bf16x8*)(ap + 32 * ks);
#pragma unroll
        for (int t = 0; t < 4; ++t) acc[t] = MFMA16(a, *(const bf16x8*)(bp + (size_t)(16 * t) * DM + 32 * ks), acc[t]); }
    bf16_t* U = WSP(bf16_t, WS_H);
#pragma unroll
    for (int t = 0; t < 4; ++t)
#pragma unroll
        for (int r = 0; r < 4; ++r) U[(size_t)(R_META + 4 * g + r) * DFF2 + n0 + 16 * t + l15] = f2bf(acc[t][r]);
}

__device__ __forceinline__ float rs2_of(const float* ss2, int row, int lane) { float v = lane < 32 ? ss2[row * 32 + lane] : 0.f; return __builtin_amdgcn_rsqf(wave_sum(v) * (1.f / DM) + EPS); }
__device__ __forceinline__ void ld8f(const float* p, float (&v)[8]) { const f32x4 a = *(const f32x4*)p, b = *(const f32x4*)(p + 4); v[0] = a[0]; v[1] = a[1]; v[2] = a[2]; v[3] = a[3]; v[4] = b[0]; v[5] = b[1]; v[6] = b[2]; v[7] = b[3]; }
__device__ __forceinline__ void p7_conv(const Ptrs& P, const WaveCtx& C) {
    const int lane = lane_now(), tid = C.wave * 64 + lane;
    const bf16_t* __restrict__ U = WSP(bf16_t, WS_H); bf16_t* __restrict__ GT = WSP(bf16_t, WS_GATE); const float* ss2 = WSP(float, WS_SS2);
    constexpr int NPI = (T_P + 4) / 5;
    for (int ibase = 0; ibase < NPI + 128; ibase += C.ngw) {
    const int item = ibase + C.gw; int row0, nr; bool have = true;
    if (item < NPI) { row0 = 5 * item; nr = min(5, T_P - row0); } else if (item < NPI + 128) { row0 = R_SAMPLE + 4 * (item - NPI); nr = 4; } else { have = false; row0 = 0; nr = 0; }
    int pa = 0, pb = 0; const float *ha = nullptr, *hb = nullptr; float rs[7] = {1.f, 1.f, 1.f, 1.f, 1.f, 1.f, 1.f};
    if (have) {
        if (row0 < R_SAMPLE) { pa = row0 >= 2 ? row0 - 2 : R_META + 14; pb = row0 >= 1 ? row0 - 1 : R_META + 15; }
        else { const int sr = row0 - R_SAMPLE, b = sr >> 4, t = sr & 15; pa = row0 - 2; pb = row0 - 1; if (t == 0) { ha = P.cache_conv + (size_t)b * 2 * DFF2; hb = ha + DFF2; pa = pb = -1; } }
        if (pa >= 0) { rs[0] = rs2_of(ss2, pa, lane); rs[1] = rs2_of(ss2, pb, lane); }
#pragma unroll
        for (int r = 0; r < 5; ++r) if (r < nr) rs[2 + r] = rs2_of(ss2, row0 + r, lane); }
    LAS unsigned char* slot = C.lds + 16384 + C.wave * 14336;
#define P7_DMA(it_) do { if (have) { _Pragma("unroll") for (int hf = 0; hf < 2; ++hf) { const bf16_t* ub_ = U + hf * DFF + (it_) * 512 + lane * 8; \
        if (pa >= 0) { __builtin_amdgcn_global_load_lds((const unsigned*)(ub_ + (size_t)pa * DFF2), (LAS unsigned*)(slot + (hf * 7 + 0) * 1024), 16, 0, 0); \
                       __builtin_amdgcn_global_load_lds((const unsigned*)(ub_ + (size_t)pb * DFF2), (LAS unsigned*)(slot + (hf * 7 + 1) * 1024), 16, 0, 0); } \
        _Pragma("unroll") for (int r = 0; r < 5; ++r) if (r < nr) __builtin_amdgcn_global_load_lds((const unsigned*)(ub_ + (size_t)(row0 + r) * DFF2), (LAS unsigned*)(slot + (hf * 7 + 2 + r) * 1024), 16, 0, 0); } } } while (0)
#define P7_WDMA(it_) do { _Pragma("unroll") for (int q = 0; q < 2; ++q) { const int idx = tid + q * 512, arr = idx >> 7, c4 = (idx & 127) * 4, hf = arr >> 2, tp = arr & 3; \
        const float* src = (tp < 3 ? P.conv_w + (size_t)tp * DFF2 : P.conv_b) + hf * DFF + (it_) * 512 + c4; \
        __builtin_amdgcn_global_load_lds((const unsigned*)src, (LAS unsigned*)(C.lds + (((it_) & 1) ? 131072 : 0) + (C.wave * 64 + q * 512) * 16), 16, 0, 0); } } while (0)
    P7_DMA(0); P7_WDMA(0);
    auto p7_block = [&](const int it, const int wofs_) __attribute__((always_inline)) { const int n = (it * 64 + lane) * 8;
        LAS const float* wl = (LAS const float*)(C.lds + wofs_);
        u32x4 ub[2][7];
        asm volatile("s_waitcnt vmcnt(0)" ::: "memory");
        __syncthreads();
        if (it + 1 < 11) P7_WDMA(it + 1);
        if (have) {
#pragma unroll
            for (int hf = 0; hf < 2; ++hf) { const int nn = n + hf * DFF;
                if (pa >= 0) { ub[hf][0] = *(LAS const u32x4*)(slot + (hf * 7 + 0) * 1024 + lane * 16); ub[hf][1] = *(LAS const u32x4*)(slot + (hf * 7 + 1) * 1024 + lane * 16); }
                else { float t0[8], t1[8]; ld8f(ha + nn, t0); ld8f(hb + nn, t1); ub[hf][0] = pack8(t0); ub[hf][1] = pack8(t1); }
#pragma unroll
                for (int r = 0; r < 5; ++r) if (r < nr) ub[hf][2 + r] = *(LAS const u32x4*)(slot + (hf * 7 + 2 + r) * 1024 + lane * 16); } }
        asm volatile("s_waitcnt lgkmcnt(0)" ::: "memory");
        if (it + 1 < 11) P7_DMA(it + 1);
        if (have) { float c0[5][8];
#pragma unroll
            for (int hf = 0; hf < 2; ++hf) { float u[7][8], w[4][8];
#pragma unroll
                for (int r = 0; r < 7; ++r) { if (r >= 2 && r - 2 >= nr) continue; const u32x4 x = ub[hf][r];
                    u[r][0] = bflo(x.x) * rs[r]; u[r][1] = bfhi(x.x) * rs[r]; u[r][2] = bflo(x.y) * rs[r]; u[r][3] = bfhi(x.y) * rs[r]; u[r][4] = bflo(x.z) * rs[r]; u[r][5] = bfhi(x.z) * rs[r]; u[r][6] = bflo(x.w) * rs[r]; u[r][7] = bfhi(x.w) * rs[r]; }
#pragma unroll
                for (int tp = 0; tp < 4; ++tp) { const f32x4 a = *(LAS const f32x4*)(wl + (hf * 4 + tp) * 512 + lane * 8), b = *(LAS const f32x4*)(wl + (hf * 4 + tp) * 512 + lane * 8 + 4);
                    w[tp][0] = a[0]; w[tp][1] = a[1]; w[tp][2] = a[2]; w[tp][3] = a[3]; w[tp][4] = b[0]; w[tp][5] = b[1]; w[tp][6] = b[2]; w[tp][7] = b[3]; }
#pragma unroll
                for (int r = 0; r < 5; ++r) { if (r >= nr) continue; const int row = row0 + r;
                    float* cvo = nullptr;
                    if (row >= T_P - 2 && row < T_P) cvo = P.out + O_CVP + (size_t)(row - (T_P - 2)) * DFF2;
                    else if (row >= R_SAMPLE && ((row - R_SAMPLE) & 15) >= 14) cvo = P.out + O_CVS + (size_t)(((row - R_SAMPLE) >> 4) * 2 + (((row - R_SAMPLE) & 15) - 14)) * DFF2;
                    if (cvo) { float* o = cvo + n + hf * DFF; *(f32x4*)o = (f32x4){u[r + 2][0], u[r + 2][1], u[r + 2][2], u[r + 2][3]}; *(f32x4*)(o + 4) = (f32x4){u[r + 2][4], u[r + 2][5], u[r + 2][6], u[r + 2][7]}; }
#pragma unroll
                    for (int q = 0; q < 8; ++q) { const float c = w[3][q] + w[0][q] * u[r][q] + w[1][q] * u[r + 1][q] + w[2][q] * u[r + 2][q];
                        if (hf == 0) c0[r][q] = c; else c0[r][q] = c0[r][q] * sigmoidf_(c0[r][q]) * c; }
                    if (hf == 1) *(u32x4*)(GT + (size_t)row * DFF + n) = pack8(c0[r]); } }
        }
    };
#pragma unroll 1
    for (int it = 0; it < 11; it += 2) { p7_block(it, 0); if (it + 1 < 11) p7_block(it + 1, 131072); }
    }
#undef P7_DMA
#undef P7_WDMA
}


__device__ __forceinline__ void p9_final(const Ptrs& P, const WaveCtx& C) {
    const int lane = lane_now();
    for (int row0 = C.gw; row0 < R_META; row0 += 4 * C.ngw) {
        f32x4 v[4][8]; float ss[4];
#pragma unroll
        for (int q = 0; q < 4; ++q) { const int row = row0 + q * C.ngw; const float* x = P.out + (size_t)(row < R_META ? row : row0) * DM;
#pragma unroll
            for (int j = 0; j < 8; ++j) v[q][j] = *(const f32x4*)(x + (j * 64 + lane) * 4); }
#pragma unroll
        for (int q = 0; q < 4; ++q) { float s_ = 0.f;
#pragma unroll
            for (int j = 0; j < 8; ++j) s_ += (v[q][j][0] * v[q][j][0] + v[q][j][1] * v[q][j][1]) + (v[q][j][2] * v[q][j][2] + v[q][j][3] * v[q][j][3]);
            ss[q] = __builtin_amdgcn_rsqf(wave_sum(s_) * (1.f / DM) + EPS); }
#pragma unroll
        for (int j = 0; j < 8; ++j) { const f32x4 g = *(const f32x4*)(P.final_norm + (j * 64 + lane) * 4);
#pragma unroll
            for (int q = 0; q < 4; ++q) { const int row = row0 + q * C.ngw; if (row < R_META) *(f32x4*)(P.out + (size_t)row * DM + (j * 64 + lane) * 4) = v[q][j] * ss[q] * g; } }
    }
}
__device__ __forceinline__ int crow(int r, int hi) { return (r & 3) + 8 * (r >> 2) + 4 * hi; }
__device__ __forceinline__ float hswap_max(float v) { auto rr = __builtin_amdgcn_permlane32_swap(__float_as_uint(v), __float_as_uint(v), false, false); return fmaxf(__uint_as_float(rr[0]), __uint_as_float(rr[1])); }
__device__ __forceinline__ float hswap_sum(float v) { auto rr = __builtin_amdgcn_permlane32_swap(__float_as_uint(v), __float_as_uint(v), false, false); return __uint_as_float(rr[0]) + __uint_as_float(rr[1]); }

constexpr int AT_KN = 16384, AT_KP = 8192, AT_V = 16384, AT_BUF = AT_KN + AT_KP + AT_V;
static_assert(3 * AT_BUF <= MISC_OFF, "attention LDS");
__device__ __forceinline__ void attn_prompt_unit(const Ptrs& P, LAS unsigned char* lds, const int wid, int h, int qrow0, int nprompt, int tlim0) {
    const int lane = lane_now(), r32 = lane & 31, hi = lane >> 5;
    bf16_t* Q = WSP(bf16_t, WS_Q); const bf16_t* KV = WSP(bf16_t, WS_KV); const bf16_t* KPE = WSP(bf16_t, WS_KPE);
    const int NT = nprompt + 1, tlim = tlim0 + (wid >> 1);
    bf16x8 qn[8], qp[4];
    { const bf16_t* qrow = Q + (size_t)(qrow0 + wid * 32 + r32) * QP;
#pragma unroll
      for (int ks = 0; ks < 8; ++ks) qn[ks] = *(const bf16x8*)(qrow + h * 128 + ks * 16 + hi * 8);
#pragma unroll
      for (int ks = 0; ks < 4; ++ks) qp[ks] = *(const bf16x8*)(qrow + 2048 + h * 64 + ks * 16 + hi * 8); }
    const int l4 = lane >> 4, c16 = lane & 15;
    const unsigned okn0 = (unsigned)((8 * wid + l4) * 4096 + (c16 ^ ((8 * wid + l4) & 15)) * 8) * 2u, okn1 = (unsigned)((8 * wid + 4 + l4) * 4096 + (c16 ^ ((8 * wid + 4 + l4) & 15)) * 8) * 2u;
    const unsigned ov0 = (unsigned)((8 * wid + l4) * 4096 + 2048 + (c16 ^ ((l4 & 3) << 2)) * 8) * 2u;
    const unsigned okp = (unsigned)((8 * wid + (lane >> 3)) * 64 + ((lane & 7) ^ (((8 * wid + (lane >> 3)) >> 1) & 7)) * 8) * 2u;
#define AT_DMA(t, bo_) do { const int kvr = (t) == 0 ? 32 * 256 : ((t) - 1) * 64; const int kpr = (t) == 0 ? R_META : ((t) - 1) * 64; \
        const char* kb_ = (const char*)(KV + (size_t)kvr * 4096 + h * 128); const char* pb_ = (const char*)(KPE + (size_t)kpr * 64); \
        __builtin_amdgcn_global_load_lds((const unsigned*)(kb_ + okn0), (LAS unsigned*)(lds + (bo_) + (2 * wid) * 1024), 16, 0, 0); \
        __builtin_amdgcn_global_load_lds((const unsigned*)(kb_ + okn1), (LAS unsigned*)(lds + (bo_) + (2 * wid + 1) * 1024), 16, 0, 0); \
        __builtin_amdgcn_global_load_lds((const unsigned*)(pb_ + okp), (LAS unsigned*)(lds + (bo_) + AT_KN + wid * 1024), 16, 0, 0); \
        __builtin_amdgcn_global_load_lds((const unsigned*)(kb_ + ov0), (LAS unsigned*)(lds + (bo_) + AT_KN + AT_KP + (2 * wid) * 1024), 16, 0, 0); \
        __builtin_amdgcn_global_load_lds((const unsigned*)(kb_ + ov0 + 4u * 4096u * 2u), (LAS unsigned*)(lds + (bo_) + AT_KN + AT_KP + (2 * wid + 1) * 1024), 16, 0, 0); } while (0)
    f32x16 o[4]; for (int d = 0; d < 4; ++d) o[d] = (f32x16){0.f, 0.f, 0.f, 0.f, 0.f, 0.f, 0.f, 0.f, 0.f, 0.f, 0.f, 0.f, 0.f, 0.f, 0.f, 0.f};
    float m_run = -1e30f, l_run = 0.f;
    const int vq_ = (lane & 15) >> 2, vin_ = (4 * hi + vq_) * 256 + 32 * ((lane >> 4) & 1) + 8 * (lane & 3);
    const int vb0 = vin_ + ((0 ^ vq_) << 6), vb1 = vin_ + ((1 ^ vq_) << 6), vb2 = vin_ + ((2 ^ vq_) << 6), vb3 = vin_ + ((3 ^ vq_) << 6);
    AT_DMA(0, 0);
    if (NT > 1) AT_DMA(1, AT_BUF);
    asm volatile("" :: "v"(qn[0]), "v"(qn[1]), "v"(qn[2]), "v"(qn[3]), "v"(qn[4]), "v"(qn[5]), "v"(qn[6]), "v"(qn[7]), "v"(qp[0]), "v"(qp[1]), "v"(qp[2]), "v"(qp[3]));
#define AT_PVD 4
#define AT_VRD(lo_, hh_, m_) do { const unsigned va_ = vbo_ + (unsigned)(((m_) & 3) == 0 ? vb0 : ((m_) & 3) == 1 ? vb1 : ((m_) & 3) == 2 ? vb2 : vb3); \
        asm volatile("ds_read_b64_tr_b16 %0, %1 offset:%2" : "=v"(lo_) : "v"(va_), "n"((16 * ((m_) >> 2)) * 256)); \
        asm volatile("ds_read_b64_tr_b16 %0, %1 offset:%2" : "=v"(hh_) : "v"(va_), "n"((16 * ((m_) >> 2) + 8) * 256)); } while (0)
#define AT_PV(bo_) do { const unsigned vbo_ = (unsigned)(size_t)(lds + (bo_) + AT_KN + AT_KP); s16x4 vl_[AT_PVD], vh_[AT_PVD]; __builtin_amdgcn_s_setprio(1); \
        _Pragma("unroll") for (int m = 0; m < AT_PVD; ++m) AT_VRD(vl_[m], vh_[m], m); \
        _Pragma("unroll") for (int m = 0; m < 16; ++m) { \
            if (m <= 16 - AT_PVD) asm volatile("s_waitcnt lgkmcnt(6)" : "+v"(vl_[m % AT_PVD]), "+v"(vh_[m % AT_PVD])); else if (m == 13) asm volatile("s_waitcnt lgkmcnt(4)" : "+v"(vl_[m % AT_PVD]), "+v"(vh_[m % AT_PVD])); \
            else if (m == 14) asm volatile("s_waitcnt lgkmcnt(2)" : "+v"(vl_[m % AT_PVD]), "+v"(vh_[m % AT_PVD])); else asm volatile("s_waitcnt lgkmcnt(0)" : "+v"(vl_[m % AT_PVD]), "+v"(vh_[m % AT_PVD])); \
            const bf16x8 pf_ = (m >> 2) == 0 ? pf0 : (m >> 2) == 1 ? pf1 : (m >> 2) == 2 ? pf2 : pf3; \
            o[m & 3] = MFMA32(cat8(vl_[m % AT_PVD], vh_[m % AT_PVD]), pf_, o[m & 3]); \
            if (m + AT_PVD < 16) AT_VRD(vl_[m % AT_PVD], vh_[m % AT_PVD], m + AT_PVD); } \
        __builtin_amdgcn_s_setprio(0); } while (0)
#define AT_PACK(P, B) __builtin_bit_cast(bf16x8, (u32x4){pk2(P[B + 0], P[B + 1]), pk2(P[B + 2], P[B + 3]), pk2(P[B + 4], P[B + 5]), pk2(P[B + 6], P[B + 7])})
    int bo = 0, bo2 = 2 * AT_BUF;
    for (int t = 0; t < NT; ++t) {
        if (t + 1 < NT) asm volatile("s_waitcnt vmcnt(5)" ::: "memory"); else asm volatile("s_waitcnt vmcnt(0)" ::: "memory");
        __syncthreads();
        if (t + 2 < NT) AT_DMA(t + 2, bo2);
        const bool act = (t == 0 || (t - 1) <= tlim);
        if (act) {
            LAS const unsigned char* bb = lds + bo;
            f32x16 p[2];
            p[0] = (f32x16){0.f, 0.f, 0.f, 0.f, 0.f, 0.f, 0.f, 0.f, 0.f, 0.f, 0.f, 0.f, 0.f, 0.f, 0.f, 0.f}; p[1] = p[0];
            { const unsigned c0 = (unsigned)((hi * 16) ^ ((r32 & 15) << 4)), c0p = (unsigned)((hi * 16) ^ (((r32 >> 1) & 7) << 4));
              const unsigned rbn = (unsigned)(size_t)(bb + r32 * 256), rbp = (unsigned)(size_t)(bb + AT_KN + r32 * 128);
#define AT_KRDA(dst, i) do { if (((i) >> 1) < 8) { const unsigned a_ = rbn + ((unsigned)(((i) >> 1) * 32) ^ c0); asm volatile("ds_read_b128 %0, %1 offset:%2" : "=v"(dst) : "v"(a_), "n"(((i) & 1) * 8192)); } \
                  else { const unsigned a_ = rbp + ((unsigned)((((i) >> 1) - 8) * 32) ^ c0p); asm volatile("ds_read_b128 %0, %1 offset:%2" : "=v"(dst) : "v"(a_), "n"(((i) & 1) * 4096)); } } while (0)
#define AT_KW(n_, r_) asm volatile("s_waitcnt lgkmcnt(" #n_ ")" : "+v"(r_))
              bf16x8 kr[12];
#pragma unroll
              for (int i = 0; i < 12; ++i) AT_KRDA(kr[i], i);
              __builtin_amdgcn_s_setprio(1);
#pragma unroll
              for (int i = 0; i < 24; ++i) { const int ks = i >> 1; const bf16x8 qf = ks < 8 ? qn[ks < 8 ? ks : 0] : qp[ks < 8 ? 0 : ks - 8];
                  if (i <= 12) AT_KW(11, kr[i % 12]); else if (i == 13) AT_KW(10, kr[i % 12]); else if (i == 14) AT_KW(9, kr[i % 12]); else if (i == 15) AT_KW(8, kr[i % 12]); else if (i == 16) AT_KW(7, kr[i % 12]);
                  else if (i == 17) AT_KW(6, kr[i % 12]); else if (i == 18) AT_KW(5, kr[i % 12]); else if (i == 19) AT_KW(4, kr[i % 12]); else if (i == 20) AT_KW(3, kr[i % 12]); else if (i == 21) AT_KW(2, kr[i % 12]);
                  else if (i == 22) AT_KW(1, kr[i % 12]); else AT_KW(0, kr[i % 12]);
                  p[i & 1] = MFMA32(kr[i % 12], qf, p[i & 1]);
                  if (i + 12 < 24) AT_KRDA(kr[i % 12], i + 12); }
              __builtin_amdgcn_s_setprio(0);
#undef AT_KRDA
#undef AT_KW
            }
            if (t == 0) {
#pragma unroll
                for (int r = 0; r < 16; ++r) { if (crow(r, hi) >= N_META) p[0][r] = -INFINITY; p[1][r] = -INFINITY; } }
            float mx = p[0][0];
#pragma unroll
            for (int r = 1; r < 16; ++r) mx = fmaxf(mx, p[0][r]);
#pragma unroll
            for (int r = 0; r < 16; ++r) mx = fmaxf(mx, p[1][r]);
            mx = hswap_max(mx);
            if (!__all(mx - m_run <= 8.f)) { const float m_new = fmaxf(m_run, mx), alpha = __builtin_amdgcn_exp2f(m_run - m_new); m_run = m_new; l_run *= alpha;
#pragma unroll
                for (int d = 0; d < 4; ++d)
#pragma unroll
                    for (int r = 0; r < 16; ++r) o[d][r] *= alpha; }
            float ps = 0.f;
#pragma unroll
            for (int kb = 0; kb < 2; ++kb)
#pragma unroll
                for (int r = 0; r < 16; ++r) { p[kb][r] = __builtin_amdgcn_exp2f(p[kb][r] - m_run); ps += p[kb][r]; }
            l_run += ps;
            const bf16x8 pf0 = AT_PACK(p[0], 0), pf1 = AT_PACK(p[0], 8), pf2 = AT_PACK(p[1], 0), pf3 = AT_PACK(p[1], 8);
            AT_PV(bo);
        }
        { const int nb = bo + AT_BUF, nb2 = bo2 + AT_BUF; bo = nb >= 3 * AT_BUF ? 0 : nb; bo2 = nb2 >= 3 * AT_BUF ? 0 : nb2; }
    }
    __syncthreads();
#undef AT_PV
#undef AT_VRD
#undef AT_PACK
#undef AT_DMA
    const float inv = 1.f / hswap_sum(l_run);
    bf16_t* orow = Q + (size_t)(qrow0 + wid * 32 + r32) * QP + h * 128;
#pragma unroll
    for (int d = 0; d < 4; ++d)
#pragma unroll
        for (int g = 0; g < 4; ++g) { u32x2 w; w.x = pk2(o[d][4 * g] * inv, o[d][4 * g + 1] * inv); w.y = pk2(o[d][4 * g + 2] * inv, o[d][4 * g + 3] * inv);
            *(u32x2*)(orow + 32 * d + 8 * g + 4 * hi) = w; }
}

constexpr int SA_P = 1040, SA_RP = 32 * SA_P, SA_BUF = SA_RP + 32 * 128;
static_assert(3 * SA_BUF <= RING_BYTES, "sample attention LDS");
__device__ __forceinline__ void attn_sample_unit(const Ptrs& P, LAS unsigned char* lds, const int wid, int b, int hq) {
    const int lane = lane_now(), l15 = lane & 15, g = lane >> 4;
    const int head = hq * 4 + (wid & 3), dvh = wid >> 2;
    bf16_t* Q = WSP(bf16_t, WS_Q); const bf16_t* QL = WSP(bf16_t, WS_QLAT); const bf16_t* SKL = WSP(bf16_t, WS_SKL) + (size_t)b * TK_S * 512; const bf16_t* SKP = WSP(bf16_t, WS_SKP) + (size_t)b * TK_S * 64;
    bf16x8 qf[18];
    { const bf16_t* ql = QL + (size_t)(b * 16 + l15) * 8192 + head * 512 + 8 * g; const bf16_t* qpe = Q + (size_t)(R_SAMPLE + b * 16 + l15) * QP + 2048 + head * 64 + 8 * g;
#pragma unroll
      for (int ks = 0; ks < 16; ++ks) qf[ks] = *(const bf16x8*)(ql + ks * 32);
      qf[16] = *(const bf16x8*)qpe; qf[17] = *(const bf16x8*)(qpe + 32); }
    constexpr int NT = 33;
#define SA_DMA(t, bo) do { const int k0_ = (t) * 32 + 4 * wid; \
        _Pragma("unroll") for (int i = 0; i < 4; ++i) { const int key = min(k0_ + i, TK_S - 1); \
            __builtin_amdgcn_global_load_lds((const unsigned*)(SKL + (size_t)key * 512 + lane * 8), (LAS unsigned*)(lds + (bo) + (4 * wid + i) * SA_P), 16, 0, 0); } \
        if (lane < 32) { const int r = 4 * wid + (lane >> 3), key = min((t) * 32 + r, TK_S - 1); \
            __builtin_amdgcn_global_load_lds((const unsigned*)(SKP + (size_t)key * 64 + (((lane & 7) ^ ((r >> 1) & 7)) * 8)), (LAS unsigned*)(lds + (bo) + SA_RP + 4 * wid * 128), 16, 0, 0); } } while (0)
    f32x4 o[16]; for (int d = 0; d < 16; ++d) o[d] = (f32x4){0.f, 0.f, 0.f, 0.f};
    float m_run = -1e30f, l_run = 0.f;
    const int trb = (4 * g + (l15 >> 2)) * SA_P + (dvh * 256 + 4 * (l15 & 3)) * 2;
    const int rsw = (l15 >> 1) & 7;
    SA_DMA(0, 0); SA_DMA(1, SA_BUF);
    int bo = 0, bo2 = 2 * SA_BUF;
    for (int t = 0; t < NT; ++t) {
        if (t + 1 < NT) asm volatile("s_waitcnt vmcnt(5)" ::: "memory"); else asm volatile("s_waitcnt vmcnt(0)" ::: "memory");
        __syncthreads();
        if (t + 2 < NT) SA_DMA(t + 2, bo2);
        LAS const unsigned char* bb = lds + bo;
        f32x4 p[2]; p[0] = (f32x4){0.f, 0.f, 0.f, 0.f}; p[1] = p[0];
        { const unsigned kla = (unsigned)(size_t)(bb + l15 * SA_P + g * 16), kra0 = (unsigned)(size_t)(bb + SA_RP + l15 * 128 + ((g ^ rsw) * 16)), kra1 = (unsigned)(size_t)(bb + SA_RP + l15 * 128 + (((4 + g) ^ rsw) * 16));
#define SA_KRD(dst, i) do { if (((i) >> 1) < 16) asm volatile("ds_read_b128 %0, %1 offset:%2" : "=v"(dst) : "v"(kla), "n"(((i) & 1) * 16 * SA_P + ((i) >> 1) * 64)); \
            else if (((i) >> 1) == 16) asm volatile("ds_read_b128 %0, %1 offset:%2" : "=v"(dst) : "v"(kra0), "n"(((i) & 1) * 2048)); \
            else asm volatile("ds_read_b128 %0, %1 offset:%2" : "=v"(dst) : "v"(kra1), "n"(((i) & 1) * 2048)); } while (0)
          bf16x8 kr[6];
#pragma unroll
          for (int i = 0; i < 6; ++i) SA_KRD(kr[i], i);
#pragma unroll
          for (int i = 0; i < 36; ++i) {
              if (i <= 30) asm volatile("s_waitcnt lgkmcnt(5)" : "+v"(kr[i % 6])); else if (i == 31) asm volatile("s_waitcnt lgkmcnt(4)" : "+v"(kr[i % 6])); else if (i == 32) asm volatile("s_waitcnt lgkmcnt(3)" : "+v"(kr[i % 6]));
              else if (i == 33) asm volatile("s_waitcnt lgkmcnt(2)" : "+v"(kr[i % 6])); else if (i == 34) asm volatile("s_waitcnt lgkmcnt(1)" : "+v"(kr[i % 6])); else asm volatile("s_waitcnt lgkmcnt(0)" : "+v"(kr[i % 6]));
              p[i & 1] = MFMA16(kr[i % 6], qf[i >> 1], p[i & 1]);
              if (i + 6 < 36) SA_KRD(kr[i % 6], i + 6); }
#undef SA_KRD
        }
        if (t == NT - 1) {
#pragma unroll
            for (int blk = 0; blk < 2; ++blk)
#pragma unroll
                for (int r = 0; r < 4; ++r) if (t * 32 + 16 * blk + 4 * g + r >= TK_S) p[blk][r] = -INFINITY; }
        float mx = fmaxf(fmaxf(fmaxf(p[0][0], p[0][1]), fmaxf(p[0][2], p[0][3])), fmaxf(fmaxf(p[1][0], p[1][1]), fmaxf(p[1][2], p[1][3])));
        mx = fmaxf(mx, __shfl_xor(mx, 16)); mx = fmaxf(mx, __shfl_xor(mx, 32));
        const float m_new = fmaxf(m_run, mx), alpha = __builtin_amdgcn_exp2f(m_run - m_new); m_run = m_new;
        float ps = 0.f;
#pragma unroll
        for (int blk = 0; blk < 2; ++blk)
#pragma unroll
            for (int r = 0; r < 4; ++r) { p[blk][r] = __builtin_amdgcn_exp2f(p[blk][r] - m_new); ps += p[blk][r]; }
        l_run = l_run * alpha + ps;
        u32x4 pw; pw.x = pk2(p[0][0], p[0][1]); pw.y = pk2(p[0][2], p[0][3]); pw.z = pk2(p[1][0], p[1][1]); pw.w = pk2(p[1][2], p[1][3]);
        const bf16x8 pf = __builtin_bit_cast(bf16x8, pw);
        { const unsigned va = (unsigned)(size_t)(bb + trb);
          s16x4 va0[8], va1[8];
#define SA_TRG(dst, g4) do { _Pragma("unroll") for (int dd = 0; dd < 4; ++dd) { \
              asm volatile("ds_read_b64_tr_b16 %0, %1 offset:%2" : "=v"(dst[2 * dd]) : "v"(va), "n"(((g4) * 4 + dd) * 32)); \
              asm volatile("ds_read_b64_tr_b16 %0, %1 offset:%2" : "=v"(dst[2 * dd + 1]) : "v"(va), "n"(16 * SA_P + ((g4) * 4 + dd) * 32)); } } while (0)
#define SA_TRW(dst, n) asm volatile("s_waitcnt lgkmcnt(" #n ")" : "+v"(dst[0]), "+v"(dst[1]), "+v"(dst[2]), "+v"(dst[3]), "+v"(dst[4]), "+v"(dst[5]), "+v"(dst[6]), "+v"(dst[7]))
#define SA_PVG(src, g4) do { _Pragma("unroll") for (int dd = 0; dd < 4; ++dd) { const int d = (g4) * 4 + dd; o[d] = MFMA16(cat8(src[2 * dd], src[2 * dd + 1]), pf, o[d]); } } while (0)
#pragma unroll
          for (int d = 0; d < 16; ++d) o[d] *= alpha;
          SA_TRG(va0, 0); SA_TRG(va1, 1); SA_TRW(va0, 8); SA_PVG(va0, 0);
          SA_TRG(va0, 2); SA_TRW(va1, 8); SA_PVG(va1, 1);
          SA_TRG(va1, 3); SA_TRW(va0, 8); SA_PVG(va0, 2);
          SA_TRW(va1, 0); SA_PVG(va1, 3);
#undef SA_TRG
#undef SA_TRW
#undef SA_PVG
        }
        { const int nb = bo + SA_BUF; const int nb2 = bo2 + SA_BUF; bo = nb >= 3 * SA_BUF ? 0 : nb; bo2 = nb2 >= 3 * SA_BUF ? 0 : nb2; }
    }
    __syncthreads();
    float lt = l_run; lt += __shfl_xor(lt, 16); lt += __shfl_xor(lt, 32);
    const float inv = 1.f / lt;
    const bf16_t* wuv = WSP(bf16_t, WS_WUVT) + (size_t)(head * 128 + l15) * 512 + dvh * 256 + 4 * g;
    f32x4 oe[8]; for (int e = 0; e < 8; ++e) oe[e] = (f32x4){0.f, 0.f, 0.f, 0.f};
#pragma unroll
    for (int i = 0; i < 8; ++i) { u32x4 bw; bw.x = pk2(o[2 * i][0] * inv, o[2 * i][1] * inv); bw.y = pk2(o[2 * i][2] * inv, o[2 * i][3] * inv); bw.z = pk2(o[2 * i + 1][0] * inv, o[2 * i + 1][1] * inv); bw.w = pk2(o[2 * i + 1][2] * inv, o[2 * i + 1][3] * inv);
        const bf16x8 bf = __builtin_bit_cast(bf16x8, bw);
#pragma unroll
        for (int e = 0; e < 8; ++e) { const bf16_t* wp = wuv + (size_t)e * 16 * 512 + 32 * i; const u32x2 a0 = *(const u32x2*)wp, a1 = *(const u32x2*)(wp + 16);
            const u32x4 aw = {a0.x, a0.y, a1.x, a1.y}; oe[e] = MFMA16(__builtin_bit_cast(bf16x8, aw), bf, oe[e]); } }
    LAS float* red = (LAS float*)lds + (wid & 3) * 2048;
    if (dvh == 1) {
#pragma unroll
        for (int e = 0; e < 8; ++e) *(LAS f32x4*)(red + (e * 64 + lane) * 4) = oe[e]; }
    __syncthreads();
    if (dvh == 0) { bf16_t* orow = Q + (size_t)(R_SAMPLE + b * 16 + l15) * QP + head * 128 + 4 * g;
#pragma unroll
        for (int e = 0; e < 8; ++e) { const f32x4 v = oe[e] + *(LAS const f32x4*)(red + (e * 64 + lane) * 4); u32x2 w; w.x = pk2(v[0], v[1]); w.y = pk2(v[2], v[3]); *(u32x2*)(orow + 16 * e) = w; } }
    __syncthreads();
#undef SA_DMA
}
constexpr int GL_QP = 528, GL_KP = 144, GL_VP = 144;
constexpr int GL_QD = 0, GL_KET = 64 * GL_QP, GL_V = GL_KET + 256 * GL_KP, GL_DEC = GL_V + 64 * GL_VP, GL_OP = GL_DEC + 1024, GL_END = GL_OP + 16384;
static_assert(GL_END <= RING_BYTES, "GLA LDS");

struct GlaStage { u32x4 q[4], e[4], v; float d; };
template <bool SAMPLE>
__device__ __forceinline__ void gla_unit(const Ptrs& P, LAS unsigned char* lds, const int wid, int h, int dvb, int b  ) {
    const int lane = lane_now(), tid = wid * 64 + lane, l15 = lane & 15, g = lane >> 4, dg = wid & 3, kh = wid >> 2;
    const bf16_t* H = WSP(bf16_t, WS_H); const bf16_t* KET = WSP(bf16_t, WS_KET); bf16_t* OG = WSP(bf16_t, WS_OG);
    const int dvcol = h * 512 + dvb * 64;
    f32x4 S[8];
    if (SAMPLE) { const char* s0 = (const char*)(P.state_gla + ((size_t)(b * 4 + h) * 256 + 128 * kh) * 512 + dvb * 64 + 16 * dg); const unsigned vo = (unsigned)((4 * g) * 512 + l15) * 4u;
#pragma unroll
        for (int i = 0; i < 8; ++i) {
#pragma unroll
            for (int r = 0; r < 4; ++r) S[i][r] = *(const float*)(s0 + (vo + (unsigned)((16 * i + r) * 2048)));
            asm volatile("" ::: "memory"); } }
    else {
#pragma unroll
        for (int i = 0; i < 8; ++i) S[i] = (f32x4){0.f, 0.f, 0.f, 0.f}; }
    constexpr int nch = SAMPLE ? 1 : 129;
    const unsigned oq = (unsigned)((tid >> 5) * NH + (tid & 31) * 8) * 2u, oe = (unsigned)((tid >> 3) * 64 + (tid & 7) * 8) * 2u, ov = (unsigned)((tid >> 3) * NH + (tid & 7) * 8) * 2u;
    const u32x4 z4 = (u32x4){0u, 0u, 0u, 0u};
#define GL_JB(ci) (SAMPLE ? 128 + (b >> 2) : ((ci) == 0 ? 136 : (ci) - 1))
#define GL_LOAD(st, ci) do { const int jb_ = GL_JB(ci); const int row0_ = SAMPLE ? R_SAMPLE + 16 * b : 64 * jb_; const char* hq = (const char*)(H + (size_t)row0_ * NH + h * 256); \
        const char* kb_ = (const char*)(KET + ((size_t)(jb_ * 4 + h) * 256) * 64 + (SAMPLE ? 16 * (b & 3) : 0)); const char* hv = (const char*)(H + (size_t)row0_ * NH + HC_V + dvcol); \
        _Pragma("unroll") for (int i = 0; i < 4; ++i) { if (SAMPLE && i > 0) st.q[i] = z4; else st.q[i] = *(const u32x4*)(hq + (oq + (unsigned)i * (16u * NH * 2u))); } \
        _Pragma("unroll") for (int i = 0; i < 4; ++i) { st.e[i] = *(const u32x4*)(kb_ + (oe + (unsigned)i * 8192u)); if (SAMPLE && (tid & 7) >= 2) st.e[i] = z4; } \
        st.v = *(const u32x4*)(hv + ov); if (SAMPLE && tid >= 128) st.v = z4; \
        st.d = 0.f; if (tid < 256) st.d = SAMPLE ? WSP(float, WS_DECS)[b * 1024 + h * 256 + tid] : WSP(float, WS_DECP)[jb_ * 1024 + h * 256 + tid]; } while (0)
#define GL_WRITE(st) do { \
        _Pragma("unroll") for (int i = 0; i < 4; ++i) { const int idx = tid + i * 512, r = idx >> 5, c = idx & 31; *(LAS u32x4*)(lds + GL_QD + r * GL_QP + c * 16) = st.q[i]; } \
        _Pragma("unroll") for (int i = 0; i < 4; ++i) { const int idx = tid + i * 512, dk = idx >> 3, c = idx & 7; *(LAS u32x4*)(lds + GL_KET + dk * GL_KP + c * 16) = st.e[i]; } \
        *(LAS u32x4*)(lds + GL_V + (tid >> 3) * GL_VP + (tid & 7) * 16) = st.v; \
        if (tid < 256) *(LAS float*)(lds + GL_DEC + tid * 4) = st.d; } while (0)
#define GL_COMPUTE_S() do { bf16x8 vf[2]; \
        _Pragma("unroll") for (int k2 = 0; k2 < 2; ++k2) { LAS const unsigned char* vp = lds + GL_V + (32 * k2 + 8 * g + (l15 >> 2)) * GL_VP + (16 * dg + 4 * (l15 & 3)) * 2; vf[k2] = cat8(lds_tr(vp), lds_tr(vp + 4 * GL_VP)); } \
        _Pragma("unroll") for (int k4 = 0; k4 < 4; ++k4) { u32x4 sw; sw.x = pk2(S[2 * k4][0], S[2 * k4][1]); sw.y = pk2(S[2 * k4][2], S[2 * k4][3]); sw.z = pk2(S[2 * k4 + 1][0], S[2 * k4 + 1][1]); sw.w = pk2(S[2 * k4 + 1][2], S[2 * k4 + 1][3]); \
            const bf16x8 sf = __builtin_bit_cast(bf16x8, sw); \
            o[0] = MFMA16(sf, *(LAS const bf16x8*)(lds + GL_QD + l15 * GL_QP + (32 * (4 * kh + k4) + 8 * g) * 2), o[0]); } \
        if (kh == 1) *(LAS f32x4*)(lds + GL_OP + ((dg * 4) * 64 + lane) * 16) = o[0]; \
        _Pragma("unroll") for (int i = 0; i < 8; ++i) { const f32x4 d4 = *(LAS const f32x4*)(lds + GL_DEC + (128 * kh + 16 * i + 4 * g) * 4); S[i] *= d4; } \
        _Pragma("unroll") for (int i = 0; i < 8; ++i) { const bf16x8 af = *(LAS const bf16x8*)(lds + GL_KET + (128 * kh + 16 * i + l15) * GL_KP + (8 * g) * 2); S[i] = MFMA16(af, vf[0], S[i]); } \
    } while (0)
#define GL_RD(dst, n_) do { if ((n_) < 16) asm volatile("ds_read_b128 %0, %1 offset:%2" : "=v"(dst) : "v"(aq_), "n"(((n_) & 3) * 16 * GL_QP + ((n_) >> 2) * 64)); \
        else if ((n_) < 24) asm volatile("ds_read_b128 %0, %1 offset:%2" : "=v"(dst) : "v"(ad_), "n"(((n_) - 16) * 64)); \
        else asm volatile("ds_read_b128 %0, %1 offset:%2" : "=v"(dst) : "v"(ak_), "n"((((n_) - 24) >> 1) * 16 * GL_KP + (((n_) - 24) & 1) * 64)); } while (0)
#define GL_COMPUTE_P() do { \
        const unsigned aq_ = (unsigned)(size_t)(lds + GL_QD + l15 * GL_QP + (128 * kh + 8 * g) * 2), ad_ = (unsigned)(size_t)(lds + GL_DEC + (128 * kh + 4 * g) * 4); \
        const unsigned ak_ = (unsigned)(size_t)(lds + GL_KET + (128 * kh + l15) * GL_KP + 16 * g), av_ = (unsigned)(size_t)(lds + GL_V + (8 * g + (l15 >> 2)) * GL_VP + (16 * dg + 4 * (l15 & 3)) * 2); \
        s16x4 t0_, t1_, t2_, t3_; \
        asm volatile("ds_read_b64_tr_b16 %0, %1 offset:%2" : "=v"(t0_) : "v"(av_), "n"(0)); asm volatile("ds_read_b64_tr_b16 %0, %1 offset:%2" : "=v"(t1_) : "v"(av_), "n"(4 * GL_VP)); \
        asm volatile("ds_read_b64_tr_b16 %0, %1 offset:%2" : "=v"(t2_) : "v"(av_), "n"(32 * GL_VP)); asm volatile("ds_read_b64_tr_b16 %0, %1 offset:%2" : "=v"(t3_) : "v"(av_), "n"(36 * GL_VP)); \
        u32x4 R_[8]; \
        _Pragma("unroll") for (int n = 0; n < 8; ++n) GL_RD(R_[n], n); \
        asm volatile("s_waitcnt lgkmcnt(7)" : "+v"(R_[0]), "+v"(t0_), "+v"(t1_), "+v"(t2_), "+v"(t3_)); \
        const bf16x8 vf0_ = cat8(t0_, t1_), vf1_ = cat8(t2_, t3_); bf16x8 sf_ = vf0_; \
        _Pragma("unroll") for (int n = 0; n < 40; ++n) { \
            if (n > 0) { if (n <= 32) asm volatile("s_waitcnt lgkmcnt(7)" : "+v"(R_[n & 7])); else if (n == 33) asm volatile("s_waitcnt lgkmcnt(6)" : "+v"(R_[n & 7])); else if (n == 34) asm volatile("s_waitcnt lgkmcnt(5)" : "+v"(R_[n & 7])); \
                else if (n == 35) asm volatile("s_waitcnt lgkmcnt(4)" : "+v"(R_[n & 7])); else if (n == 36) asm volatile("s_waitcnt lgkmcnt(3)" : "+v"(R_[n & 7])); else if (n == 37) asm volatile("s_waitcnt lgkmcnt(2)" : "+v"(R_[n & 7])); \
                else if (n == 38) asm volatile("s_waitcnt lgkmcnt(1)" : "+v"(R_[n & 7])); else asm volatile("s_waitcnt lgkmcnt(0)" : "+v"(R_[n & 7])); } \
            if (n < 16) { const int k4 = n >> 2; \
                if ((n & 3) == 0) { u32x4 sw; sw.x = pk2(S[2 * k4][0], S[2 * k4][1]); sw.y = pk2(S[2 * k4][2], S[2 * k4][3]); sw.z = pk2(S[2 * k4 + 1][0], S[2 * k4 + 1][1]); sw.w = pk2(S[2 * k4 + 1][2], S[2 * k4 + 1][3]); sf_ = __builtin_bit_cast(bf16x8, sw); } \
                o[n & 3] = MFMA16(sf_, __builtin_bit_cast(bf16x8, R_[n & 7]), o[n & 3]); } \
            else if (n < 24) { S[n - 16] *= __builtin_bit_cast(f32x4, R_[n & 7]); } \
            else { const int i = (n - 24) >> 1; S[i] = MFMA16(__builtin_bit_cast(bf16x8, R_[n & 7]), ((n - 24) & 1) ? vf1_ : vf0_, S[i]); } \
            if (n + 8 < 40) GL_RD(R_[n & 7], n + 8); \
            if (n == 15 && kh == 1) { _Pragma("unroll") for (int ct = 0; ct < 4; ++ct) *(LAS f32x4*)(lds + GL_OP + ((dg * 4 + ct) * 64 + lane) * 16) = o[ct]; } } \
    } while (0)
#define GL_STEP(st, ci, cn) do { GL_WRITE(st); __syncthreads(); if (!SAMPLE && (cn) < nch) GL_LOAD(st, cn); \
        const int jb = GL_JB(ci); const int row0 = SAMPLE ? R_SAMPLE + 16 * b : 64 * jb; \
        f32x4 o[4]; \
        _Pragma("unroll") for (int ct = 0; ct < 4; ++ct) o[ct] = (f32x4){0.f, 0.f, 0.f, 0.f}; \
        if (SAMPLE) { GL_COMPUTE_S(); } else { GL_COMPUTE_P(); } \
        __syncthreads(); \
        if (kh == 0) { _Pragma("unroll") for (int ct = 0; ct < 4; ++ct) { if (SAMPLE && ct > 0) continue; const f32x4 v = o[ct] + *(LAS const f32x4*)(lds + GL_OP + ((dg * 4 + ct) * 64 + lane) * 16); \
            u32x2 w; w.x = pk2(v[0], v[1]); w.y = pk2(v[2], v[3]); *(u32x2*)(OG + (size_t)(row0 + 16 * ct + l15) * DM + dvcol + 16 * dg + 4 * g) = w; } } \
    } while (0)
    GlaStage X;
    GL_LOAD(X, 0);
    if (SAMPLE) { GL_STEP(X, 0, 1); }
    else {
        GlaStage Y;
        GL_LOAD(Y, 1);
        for (int ci = 0; ci < nch - 1; ci += 2) {
            GL_STEP(X, ci, ci + 2); GL_STEP(Y, ci + 1, ci + 3);
        }
        GL_STEP(X, nch - 1, nch + 1);
    }
    __syncthreads();
    { char* so = (char*)(P.out + (SAMPLE ? O_GSS + (size_t)(b * 4 + h) * 256 * 512 : O_GSP + (size_t)h * 256 * 512) + (size_t)(128 * kh) * 512 + dvb * 64 + 16 * dg);
      const int ln = lane_now(); const unsigned vo = (unsigned)((4 * (ln >> 4)) * 512 + (ln & 15)) * 4u;
#pragma unroll
      for (int i = 0; i < 8; ++i) {
#pragma unroll
        for (int r = 0; r < 4; ++r) *(float*)(so + (vo + (unsigned)((16 * i + r) * 2048))) = S[i][r];
        asm volatile("" ::: "memory"); } }
#undef GL_LOAD
#undef GL_WRITE
#undef GL_STEP
#undef GL_COMPUTE_S
#undef GL_COMPUTE_P
#undef GL_RD
#undef GL_JB
}
#ifndef UNIT_MASK
#define UNIT_MASK 15
#endif
#ifndef MK_N_LAUNCHES
#define MK_N_LAUNCHES 1
#endif
constexpr int N_PHASES = 10;
struct Args { const float* in[24]; float* out; unsigned char* ws; int ph_lo, ph_hi; };

__global__ void __launch_bounds__(512, 2) fwd_megakernel(Args args) {
    extern __shared__ __attribute__((aligned(16))) unsigned char lds_raw[];
    LAS unsigned char* lds = (LAS unsigned char*)lds_raw;
    volatile LAS unsigned* MISC = (volatile LAS unsigned*)(lds + MISC_OFF);
    Ptrs P;
    P.x_prompt = args.in[0]; P.x_sample = args.in[1]; P.cache_lat = args.in[2]; P.cache_krope = args.in[3]; P.state_gla = args.in[4]; P.cache_conv = args.in[5]; P.meta = args.in[6]; P.g_mix = args.in[7];
    P.w_in = args.in[8]; P.w_a2 = args.in[9]; P.b_a = args.in[10]; P.g_gla = args.in[11]; P.g_q = args.in[12]; P.w_uq = args.in[13]; P.g_kv = args.in[14]; P.w_uk = args.in[15]; P.w_uv = args.in[16]; P.w_o = args.in[17];
    P.g_ffn = args.in[18]; P.w_up = args.in[19]; P.conv_w = args.in[20]; P.conv_b = args.in[21]; P.w_down = args.in[22]; P.final_norm = args.in[23]; P.out = args.out; P.ws = args.ws;
    WaveCtx C; C.lds = lds; C.wave = __builtin_amdgcn_readfirstlane(threadIdx.x >> 6);
    const int G = gridDim.x, bx = blockIdx.x;
    C.gw = bx * 8 + C.wave; C.ngw = G * 8;
    if (threadIdx.x < 32) MISC[threadIdx.x] = 0u;
    const bool tid0 = (threadIdx.x == 0);
    __syncthreads();
    unsigned* ctl = (unsigned*)(P.ws + WS_CTL);
    const int lo = args.ph_lo, hi = args.ph_hi;
    XcdBarrier bar; bar.bar = ctl + CW_BAR; bar.x = 0; bar.st = nullptr;
    if (hi - lo > 1) bar = xcd_barrier_post(ctl + CW_BAR, MISC + 8, tid0);
#ifndef PH_MASK
#define PH_MASK 0x3ff
#endif
#define IN(k) (((PH_MASK >> (k)) & 1) && lo <= (k) && (k) < hi)
#ifndef PROBE_MASK
#define PROBE_MASK 0
#endif
    unsigned long long tps_ = (PROBE_MASK != 0) ? __builtin_amdgcn_s_memrealtime() : 0ull;
#define SEAM(k) do { if (IN(k) && IN((k) + 1)) xcd_barrier(bar, C.wave); \
        if (PROBE_MASK != 0) { const unsigned long long t1_ = __builtin_amdgcn_s_memrealtime(); if ((PROBE_MASK >> (k)) & 1) { while (__builtin_amdgcn_s_memrealtime() - t1_ < t1_ - tps_) __builtin_amdgcn_s_sleep(8); } tps_ = __builtin_amdgcn_s_memrealtime(); } } while (0)

    if (IN(0)) { p0_prologue(P, C); }
    SEAM(0);
    if (IN(1)) {
        { SchedPlain S; S.o.init(NMT, NH / 256, G, bx); S.A = (const char*)WSP(bf16_t, WS_XBF); S.Bt = (const char*)WSP(bf16_t, WS_W1T); S.a_tile = (size_t)256 * DM * 2; S.b_tile = (size_t)256 * DM * 2; S.nt = DM / 64;
          EpiInProj E{WSP(bf16_t, WS_H), WSP(float, WS_RSX), WSP(float, WS_SS)};
          pg8::gemm_phase(lds, C.wave, DM, DM, S, E); }
        p1_wabs(P, C);
        for (;;) { if (C.wave == 0 && lane_now() == 0) MISC[0] = __hip_atomic_fetch_add(ctl + CW_QUEUE1, 8u, RLX_AGENT);
            __syncthreads(); const int base = (int)MISC[0]; __syncthreads();
            if (base >= I_CACHE) break;
            const int it = base + C.wave; if (it < I_CACHE) cache_conv_item(P, it, lane_now()); }
    }
    SEAM(1);
    if (IN(2)) {
#ifdef PROBE_P2R
        const unsigned long long tr0_ = __builtin_amdgcn_s_memrealtime();
#endif
        p2_rows(P, C);
#ifdef PROBE_P2R
        { const unsigned long long tr1_ = __builtin_amdgcn_s_memrealtime(); while (__builtin_amdgcn_s_memrealtime() - tr1_ < tr1_ - tr0_) __builtin_amdgcn_s_sleep(8); }
#endif
        __syncthreads();
        SchedP2 S{G, bx, (const char*)P.ws};
        EpiP2 E{WSP(bf16_t, WS_Q), WSP(bf16_t, WS_KV), WSP(bf16_t, WS_QLAT), WSP(bf16_t, WS_WABS), WSP(float, WS_SS), WSP(f32x2, WS_ROPE)};
        pg8::gemm_phase(lds, C.wave, NH, 512, S, E);
    }
    SEAM(2);
    if (IN(3)) {
        for (;;) {
            if (C.wave == 0 && lane_now() == 0) MISC[0] = __hip_atomic_fetch_add(ctl + CW_QUEUE, 1u, RLX_AGENT);
            __syncthreads();
            const int idx = (int)MISC[0];
            __syncthreads();
            if (idx >= 1712) break;
            if (idx < 32) {
#ifdef PROBE_GLA
                const unsigned long long tg0_ = __builtin_amdgcn_s_memrealtime();
#endif
                if (UNIT_MASK & 1) gla_unit<false>(P, lds, C.wave, idx >> 3, idx & 7, 0);
#ifdef PROBE_GLA
                { const unsigned long long tg1_ = __builtin_amdgcn_s_memrealtime(); while (__builtin_amdgcn_s_memrealtime() - tg1_ < tg1_ - tg0_) __builtin_amdgcn_s_sleep(8); }
#endif
            }
            else if (idx < 160) { const int s = idx - 32;
#ifdef PROBE_SATTS
                const unsigned long long ts0_ = __builtin_amdgcn_s_memrealtime();
#endif
                if (UNIT_MASK & 4) attn_sample_unit(P, lds, C.wave, s >> 2, s & 3);
#ifdef PROBE_SATTS
                { const unsigned long long ts1_ = __builtin_amdgcn_s_memrealtime(); while (__builtin_amdgcn_s_memrealtime() - ts1_ < ts1_ - ts0_) __builtin_amdgcn_s_sleep(8); }
#endif
#ifdef PROBE_SATT2
                __syncthreads(); attn_sample_unit(P, lds, C.wave, s >> 2, s & 3);
#endif
            }
            else if (idx < 688) { int h, qrow0, npr, tl;
                if (idx < 176) { h = idx - 160; qrow0 = R_META; npr = 0; tl = 0; }
                else { const int a = idx - 176, qb = 31 - (a >> 4); h = a & 15; qrow0 = 256 * qb; npr = 4 * qb + 4; tl = 4 * qb; }
#ifdef PROBE_ATT
                const unsigned long long ta0_ = __builtin_amdgcn_s_memrealtime();
#endif
                if (UNIT_MASK & 2) attn_prompt_unit(P, lds, C.wave, h, qrow0, npr, tl);
#ifdef PROBE_ATT
                { const unsigned long long ta1_ = __builtin_amdgcn_s_memrealtime(); while (__builtin_amdgcn_s_memrealtime() - ta1_ < ta1_ - ta0_) __builtin_amdgcn_s_sleep(8); }
#endif
            }
            else { const int gs = idx - 688; if (UNIT_MASK & 8) gla_unit<true>(P, lds, C.wave, (gs >> 3) & 3, gs & 7, gs >> 5);
#ifdef PROBE_GLAS2
                __syncthreads(); gla_unit<true>(P, lds, C.wave, (gs >> 3) & 3, gs & 7, gs >> 5);
#endif
            }
        }
    }
    SEAM(3);
    if (IN(4)) {
        for (;;) { if (C.wave == 0 && lane_now() == 0) MISC[0] = __hip_atomic_fetch_add(ctl + CW_QUEUE4, 1u, RLX_AGENT);
            __syncthreads(); const int u = (int)MISC[0]; __syncthreads();
            if (u >= 137 * 4 + I_DN / 8) break;
            if (u < 137 * 4) p4_unit(P, lds, C.wave, u >> 2, u & 3);
            else ffn_wconv_item(P, lds + C.wave * 16384, I_UP + (u - 137 * 4) * 8 + C.wave, lane_now()); }
    }
    SEAM(4);
    if (IN(5)) {
        SchedPlain S; S.o.init(NMT, DM / 256, G, bx); S.A = (const char*)WSP(bf16_t, WS_MERGED); S.Bt = (const char*)WSP(bf16_t, WS_WOT); S.a_tile = (size_t)256 * DM * 2; S.b_tile = (size_t)256 * DM * 2; S.nt = DM / 64;
        EpiOut E{P.x_prompt, P.x_sample, P.meta, P.out, WSP(float, WS_X2M), WSP(bf16_t, WS_X2B), WSP(float, WS_SS2), ctl + CW_SKF5};
        pg8::gemm_phase(lds, C.wave, DM, DM, S, E);
        { LAS unsigned char* scr = lds + C.wave * 16384;
          for (;;) { if (C.wave == 0 && lane_now() == 0) MISC[0] = __hip_atomic_fetch_add(ctl + CW_QUEUE2, 8u, RLX_AGENT);
              __syncthreads(); const int base = (int)MISC[0]; __syncthreads();
              if (base >= I_UP) break;
              const int it = base + C.wave; if (it < I_UP) ffn_wconv_item(P, scr, it, lane_now()); } }
    }
    SEAM(5);
    if (IN(6)) {
        SchedPlain S; S.o.init(34, DFF2 / 256, G, bx); S.A = (const char*)WSP(bf16_t, WS_X2B); S.Bt = (const char*)WSP(bf16_t, WS_WUPT); S.a_tile = (size_t)256 * DM * 2; S.b_tile = (size_t)256 * DM * 2; S.nt = DM / 64; S.quarter = 1;
        EpiUp E{WSP(bf16_t, WS_H)};
        pg8::gemm_phase(lds, C.wave, DM, DM, S, E);
        for (;;) { if (C.wave == 0 && lane_now() == 0) MISC[0] = __hip_atomic_fetch_add(ctl + CW_QUEUE6S, 8u, RLX_AGENT);
            __syncthreads(); const int base = (int)MISC[0]; __syncthreads();
            if (base >= I_SKU) break;
            const int it = base + C.wave; if (it < I_SKU) skinny_up_item(P, it, lane_now()); }
    }
    SEAM(6);
    if (IN(7)) { p7_conv(P, C); }
    SEAM(7);
    if (IN(8)) {
        SchedSplitTail<EpiDown::NS> S; S.o.init(34, DM / 256, G, bx); S.A = (const char*)WSP(bf16_t, WS_GATE); S.Bt = (const char*)WSP(bf16_t, WS_WDT); S.a_tile = (size_t)256 * DFF * 2; S.b_tile = (size_t)256 * DFF * 2; S.nt = DFF / 64;
        EpiDown E{P.out, ctl + CW_SKF8, lds};
        pg8::gemm_phase(lds, C.wave, DFF, DFF, S, E);
    }
    SEAM(8);
    if (IN(9)) { p9_final(P, C); }
    SEAM(9);
#ifdef PROBE_BAR
    for (int q_ = 0; q_ < 10; ++q_) xcd_barrier(bar, C.wave);
#endif
#undef IN
#undef SEAM
}

extern "C" void kernel_launch(void* const* d_in, const int* in_sizes, int n_in, void* d_out, int out_size, void* d_ws, size_t ws_size, hipStream_t stream) {
    static int grid = 0;
    if (grid == 0) {
        if (n_in != 24 || out_size != (int)O_END || ws_size < WS_END) { fprintf(stderr, "kernel_launch: shape mismatch: n_in %d out %d ws %zu (need 24, %zu, >= %zu); nothing launched\n", n_in, out_size, ws_size, (size_t)O_END, (size_t)WS_END); grid = -1; return; }
        int dev = 0, cus = 0, per_cu = 0;
        if (hipGetDevice(&dev) != hipSuccess || hipDeviceGetAttribute(&cus, hipDeviceAttributeMultiprocessorCount, dev) != hipSuccess) { fprintf(stderr, "kernel_launch: device query failed\n"); grid = -1; return; }
        if (hipFuncSetAttribute((const void*)fwd_megakernel, hipFuncAttributeMaxDynamicSharedMemorySize, LDS_BYTES) != hipSuccess) { fprintf(stderr, "kernel_launch: hipFuncSetAttribute failed\n"); grid = -1; return; }
        if (hipOccupancyMaxActiveBlocksPerMultiprocessor(&per_cu, (const void*)fwd_megakernel, 512, LDS_BYTES) != hipSuccess || per_cu < 1) { fprintf(stderr, "kernel_launch: occupancy query reports %d blocks per CU\n", per_cu); per_cu = 1; }
        (void)hipGetLastError();
        grid = cus;
        fprintf(stderr, "kernel_launch: grid %d (cus %d, occupancy %d/CU), ws %zu\n", grid, cus, per_cu, ws_size);
    }
    if (grid < 0) return;
    if (hipMemsetAsync((char*)d_ws + WS_CTL, 0, CTL_ZERO_BYTES, stream) != hipSuccess) { fprintf(stderr, "kernel_launch: memset failed\n"); return; }
    Args a{};
    for (int i = 0; i < 24; ++i) a.in[i] = (const float*)d_in[i];
    a.out = (float*)d_out; a.ws = (unsigned char*)d_ws;
    if (MK_N_LAUNCHES == 1) { a.ph_lo = 0; a.ph_hi = N_PHASES; hipLaunchKernelGGL(fwd_megakernel, dim3(grid), dim3(512), LDS_BYTES, stream, a); }
    else { for (int p = 0; p < N_PHASES; ++p) { a.ph_lo = p; a.ph_hi = p + 1; hipLaunchKernelGGL(fwd_megakernel, dim3(grid), dim3(512), LDS_BYTES, stream, a); } }
    const hipError_t le = hipPeekAtLastError();
    if (le != hipSuccess) fprintf(stderr, "kernel_launch: launch failed: %s\n", hipGetErrorName(le));
}
```
